# Optimizing an MI355X kernel written in HIP

```python
import math
import jax, jax.numpy as jnp
from jax import lax
import numpy as np

D_MODEL = 2048
BATCH = 4
SEQ = 2048
DEPTH = 1

GRID_W = 64
CTX_LEN = 256
MIX_WIDTH = D_MODEL
POOL_WIDTH = MIX_WIDTH // 2
POOL_WINDOWS = (2, 4, 8, 16)
POOL_GROUP = POOL_WIDTH // len(POOL_WINDOWS)
ATTN_WIDTH = MIX_WIDTH - POOL_WIDTH
N_HEADS = 8
V_HEAD_DIM = ATTN_WIDTH // N_HEADS
QK_HEAD_DIM = V_HEAD_DIM // 2
ROPE_AXIS_DIM = QK_HEAD_DIM // 2
ROPE_BASE = 10000.0
D_FF = -(-8 * D_MODEL // 768) * 256
Q_BLOCK = 128
IN_WIDTH = POOL_WIDTH + 3 * ATTN_WIDTH
N_MOD = 6
EPS = 1e-6

kernel_name = "hybrid_pool_diffattn_dit_block"


def rmsnorm(x, g):
    xf = x.astype(jnp.float32)
    y = xf * lax.rsqrt(jnp.mean(xf * xf, axis=-1, keepdims=True) + EPS)
    return (y * g.astype(jnp.float32)).astype(x.dtype)


def axial_rope_tables(n_tokens):
    rows = n_tokens // GRID_W
    row = jnp.repeat(jnp.arange(rows), GRID_W)
    col = jnp.tile(jnp.arange(GRID_W), rows)
    half = ROPE_AXIS_DIM // 2
    inv = ROPE_BASE ** (-jnp.arange(half, dtype=jnp.float32) / half)
    ang_r = row.astype(jnp.float32)[:, None] * inv
    ang_c = col.astype(jnp.float32)[:, None] * inv
    return (jnp.cos(ang_r)[None, :, None, :], jnp.sin(ang_r)[None, :, None, :],
            jnp.cos(ang_c)[None, :, None, :], jnp.sin(ang_c)[None, :, None, :])


def _rotate(x, cos, sin):
    x1, x2 = jnp.split(x, 2, axis=-1)
    return jnp.concatenate([x1 * cos - x2 * sin, x1 * sin + x2 * cos], axis=-1)


def apply_axial_rope(x, tables):
    cr, sr, cc, sc = tables
    xf = x.astype(jnp.float32)
    out = jnp.concatenate([_rotate(xf[..., :ROPE_AXIS_DIM], cr, sr),
                           _rotate(xf[..., ROPE_AXIS_DIM:], cc, sc)], axis=-1)
    return out.astype(x.dtype)


def pool_mixer(u, w_pool_l, pool_scale_l):
    b, n = u.shape[0], u.shape[1]
    uf = u.astype(jnp.float32)
    cs = jnp.concatenate([jnp.zeros((b, 1, POOL_WIDTH), jnp.float32),
                          jnp.cumsum(uf, axis=1)], axis=1)
    t = jnp.arange(n)
    outs = []
    for g, w in enumerate(POOL_WINDOWS):
        lo = jnp.clip(t - w // 2, 0, n)
        hi = jnp.clip(t + w // 2, 0, n)
        sl = slice(g * POOL_GROUP, (g + 1) * POOL_GROUP)
        seg = cs[:, :, sl]
        mean = (seg[:, hi] - seg[:, lo]) / (hi - lo).astype(jnp.float32)[None, :, None]
        d = (mean - uf[:, :, sl]).astype(u.dtype)
        outs.append(jnp.einsum('blc,cd->bld', d, w_pool_l[g]))
    return jnp.concatenate(outs, axis=-1) * pool_scale_l


def project(h, w_in_l):
    b, n = h.shape[0], h.shape[1]
    proj = h @ w_in_l
    p = proj[..., :POOL_WIDTH]
    q = proj[..., POOL_WIDTH:POOL_WIDTH + ATTN_WIDTH].reshape(b, n, N_HEADS, 2, QK_HEAD_DIM)
    k = proj[..., POOL_WIDTH + ATTN_WIDTH:POOL_WIDTH + 2 * ATTN_WIDTH].reshape(b, n, N_HEADS, 2, QK_HEAD_DIM)
    v = proj[..., POOL_WIDTH + 2 * ATTN_WIDTH:].reshape(b, n, N_HEADS, V_HEAD_DIM)
    return p, q[..., 0, :], q[..., 1, :], k[..., 0, :], k[..., 1, :], v


def diff_attend(q1, q2, k1, k2, v, lam):
    scale = QK_HEAD_DIM ** -0.5
    s1 = jnp.einsum('bqhd,bkhd->bhqk', q1, k1).astype(jnp.float32) * scale
    s2 = jnp.einsum('bqhd,bkhd->bhqk', q2, k2).astype(jnp.float32) * scale
    p = jax.nn.softmax(s1, axis=-1) - lam * jax.nn.softmax(s2, axis=-1)
    return jnp.einsum('bhqk,bkhe->bqhe', p.astype(v.dtype), v)


def diff_attend_blocked(q1, q2, k1, k2, v, lam):
    b, n = q1.shape[0], q1.shape[1]
    nb = n // Q_BLOCK

    def to_blocks(q):
        return q.reshape(b, nb, Q_BLOCK, N_HEADS, QK_HEAD_DIM).swapaxes(0, 1)

    out = lax.map(lambda qs: diff_attend(qs[0], qs[1], k1, k2, v, lam),
                  (to_blocks(q1), to_blocks(q2)))
    return out.swapaxes(0, 1).reshape(b, n, N_HEADS, V_HEAD_DIM)


def swiglu(h, w_gate_up_l, w_down_l):
    gu = h @ w_gate_up_l
    g, u = jnp.split(gu, 2, axis=-1)
    return (jax.nn.silu(g) * u) @ w_down_l


def setup_inputs(seed: int = 0) -> dict:
    key = jax.random.key(seed)
    ks = jax.random.split(key, 24)
    f32 = jnp.float32

    def nrm(k, shape, scale):
        return jax.random.normal(k, shape, f32) * scale

    def gain(k, shape):
        return 1.0 + 0.02 * jax.random.normal(k, shape, f32)

    return {
        "x": nrm(ks[0], (BATCH, SEQ, D_MODEL), 1.0),
        "c": nrm(ks[1], (BATCH, D_MODEL), 1.0),
        "ctx": nrm(ks[2], (BATCH, CTX_LEN, D_MODEL), 1.0),
        "c_ctx": nrm(ks[3], (D_MODEL,), 1.0),
        "w_ada": nrm(ks[4], (DEPTH, D_MODEL, N_MOD * D_MODEL), D_MODEL ** -0.5),
        "b_ada": nrm(ks[5], (DEPTH, N_MOD * D_MODEL), 0.01),
        "g_pre_mix": gain(ks[6], (DEPTH, D_MODEL)),
        "g_post_mix": gain(ks[7], (DEPTH, D_MODEL)),
        "g_pre_ffn": gain(ks[8], (DEPTH, D_MODEL)),
        "g_post_ffn": gain(ks[9], (DEPTH, D_MODEL)),
        "w_in": nrm(ks[10], (DEPTH, D_MODEL, IN_WIDTH), D_MODEL ** -0.5),
        "w_pool": nrm(ks[11], (DEPTH, len(POOL_WINDOWS), POOL_GROUP, POOL_GROUP), POOL_GROUP ** -0.5),
        "pool_scale": gain(ks[12], (DEPTH, POOL_WIDTH)),
        "lambda_q1": nrm(ks[13], (DEPTH, QK_HEAD_DIM), 0.1),
        "lambda_k1": nrm(ks[14], (DEPTH, QK_HEAD_DIM), 0.1),
        "lambda_q2": nrm(ks[15], (DEPTH, QK_HEAD_DIM), 0.1),
        "lambda_k2": nrm(ks[16], (DEPTH, QK_HEAD_DIM), 0.1),
        "g_subln": gain(ks[17], (DEPTH, V_HEAD_DIM)),
        "w_out": nrm(ks[18], (DEPTH, MIX_WIDTH, D_MODEL), MIX_WIDTH ** -0.5),
        "w_gate_up": nrm(ks[19], (DEPTH, D_MODEL, 2 * D_FF), D_MODEL ** -0.5),
        "w_down": nrm(ks[20], (DEPTH, D_FF, D_MODEL), D_FF ** -0.5),
    }


def reference(x, c, ctx, c_ctx, w_ada, b_ada, g_pre_mix, g_post_mix, g_pre_ffn, g_post_ffn,
              w_in, w_pool, pool_scale, lambda_q1, lambda_k1, lambda_q2, lambda_k2, g_subln,
              w_out, w_gate_up, w_down):
    b, n = x.shape[0], x.shape[1]
    tables = axial_rope_tables(n)
    silu_c = jax.nn.silu(c)
    silu_cc = jax.nn.silu(c_ctx)

    for l in range(DEPTH):
        lambda_init = 0.8 - 0.6 * math.exp(-0.3 * l)
        lam = (jnp.exp(jnp.sum(lambda_q1[l].astype(jnp.float32) * lambda_k1[l].astype(jnp.float32)))
               - jnp.exp(jnp.sum(lambda_q2[l].astype(jnp.float32) * lambda_k2[l].astype(jnp.float32)))
               + lambda_init)

        mod = silu_c @ w_ada[l] + b_ada[l]
        sh_m, sc_m, gt_m, sh_f, sc_f, gt_f = jnp.split(mod[:, None, :], N_MOD, axis=-1)
        mod_c = silu_cc @ w_ada[l] + b_ada[l]
        shc_m, scc_m, gtc_m, shc_f, scc_f, gtc_f = jnp.split(mod_c, N_MOD, axis=-1)

        h = rmsnorm(x, g_pre_mix[l]) * (1 + sc_m) + sh_m
        hc = rmsnorm(ctx, g_pre_mix[l]) * (1 + scc_m) + shc_m
        p, q1, q2, k1, k2, v = project(h, w_in[l])
        pc, q1c, q2c, k1c, k2c, vc = project(hc, w_in[l])

        q1 = apply_axial_rope(q1, tables)
        q2 = apply_axial_rope(q2, tables)
        k1 = apply_axial_rope(k1, tables)
        k2 = apply_axial_rope(k2, tables)
        k1_all = jnp.concatenate([k1c, k1], axis=1)
        k2_all = jnp.concatenate([k2c, k2], axis=1)
        v_all = jnp.concatenate([vc, v], axis=1)

        attn = diff_attend_blocked(q1, q2, k1_all, k2_all, v_all, lam)
        attn = rmsnorm(attn, g_subln[l]) * (1 - lambda_init)
        pool = pool_mixer(p, w_pool[l], pool_scale[l])
        mix = jnp.concatenate([pool, attn.reshape(b, n, ATTN_WIDTH)], axis=-1) @ w_out[l]
        x_new = x + gt_m * rmsnorm(mix, g_post_mix[l])

        h2 = rmsnorm(x_new, g_pre_ffn[l]) * (1 + sc_f) + sh_f
        x_new = x_new + gt_f * rmsnorm(swiglu(h2, w_gate_up[l], w_down[l]), g_post_ffn[l])

        if l < DEPTH - 1:
            attn_c = diff_attend(q1c, q2c, k1c, k2c, vc, lam)
            attn_c = rmsnorm(attn_c, g_subln[l]) * (1 - lambda_init)
            pool_c = pool_mixer(pc, w_pool[l], pool_scale[l])
            mix_c = jnp.concatenate([pool_c, attn_c.reshape(b, ctx.shape[1], ATTN_WIDTH)], axis=-1) @ w_out[l]
            ctx = ctx + gtc_m * rmsnorm(mix_c, g_post_mix[l])
            h2c = rmsnorm(ctx, g_pre_ffn[l]) * (1 + scc_f) + shc_f
            ctx = ctx + gtc_f * rmsnorm(swiglu(h2c, w_gate_up[l], w_down[l]), g_post_ffn[l])

        x = x_new

    return x
```

```cpp
#include <hip/hip_runtime.h>
#include <cstdio>
#include <cstdint>

#define GAS __attribute__((address_space(1)))
#define LAS __attribute__((address_space(3)))
typedef unsigned short bf16_t;
typedef short bf16x8 __attribute__((ext_vector_type(8)));
typedef float f32x4 __attribute__((ext_vector_type(4)));
typedef float f32x2 __attribute__((ext_vector_type(2)));
typedef unsigned u32x4 __attribute__((ext_vector_type(4)));
typedef unsigned u32x2 __attribute__((ext_vector_type(2)));

constexpr int DM = 2048, NB = 4, SEQ = 2048, CTXL = 256, MLAT = NB * SEQ, MCTX = NB * CTXL, MALL = MLAT + MCTX;
constexpr int NIN = 4096, POOLW = 1024, ATTW = 1024, NH = 8, VHD = 128, QKD = 64, DFF = 5632, NMOD = 6 * DM, KVL = CTXL + SEQ;
constexpr int NBM = NB + 1;
constexpr int KSLAB = 8;
constexpr float EPS = 1e-6f;
constexpr float QSCALE = 0.125f * 1.4426950408889634f;
constexpr float LAMBDA_INIT = 0.2f;

constexpr size_t MiB = 1u << 20;
constexpr size_t WS_CTL = 0, CTL_ZERO_BYTES = 1 * MiB;
constexpr size_t WS_MODP = 1 * MiB;
constexpr size_t WS_MOD = 3 * MiB;
constexpr size_t WS_ROPE = 3 * MiB + 512 * 1024;
constexpr size_t WS_WPOOL = 4 * MiB;
constexpr size_t WS_WIN = 8 * MiB;
constexpr size_t WS_WOUT = 24 * MiB;
constexpr size_t WS_WGU = 32 * MiB;
constexpr size_t WS_WDN = 76 * MiB;
constexpr size_t WS_H = 98 * MiB;
constexpr size_t WS_P = 134 * MiB;
constexpr size_t WS_Q = 150 * MiB;
constexpr size_t WS_K = 166 * MiB;
constexpr size_t WS_V = 184 * MiB;
constexpr size_t WS_DP = 202 * MiB;
constexpr size_t WS_MIXIN = 218 * MiB;
constexpr size_t WS_ACT = 134 * MiB;
constexpr size_t WS_MIX = 250 * MiB;
constexpr size_t WS_END = 314 * MiB;

struct Ptrs {
    const float *x, *c, *ctx, *c_ctx, *w_ada, *b_ada, *g_pre_mix, *g_post_mix, *g_pre_ffn, *g_post_ffn, *w_in, *w_pool, *pool_scale;
    const float *lq1, *lk1, *lq2, *lk2, *g_subln, *w_out, *w_gu, *w_dn;
    float* out; unsigned char* ws;
};

__device__ __forceinline__ unsigned f2bf(float f) { unsigned u = __builtin_bit_cast(unsigned, f); return (u + 0x7fffu + ((u >> 16) & 1u)) >> 16; }
__device__ __forceinline__ unsigned pk2(float lo, float hi) { return f2bf(lo) | (f2bf(hi) << 16); }
__device__ __forceinline__ float bf2f(unsigned short b) { return __builtin_bit_cast(float, (unsigned)b << 16); }
__device__ __forceinline__ float wave_sum(float v) {
#pragma unroll
    for (int o = 1; o < 64; o <<= 1) v += __shfl_xor(v, o);
    return v;
}
__device__ __forceinline__ float wave_max(float v) {
#pragma unroll
    for (int o = 1; o < 64; o <<= 1) v = fmaxf(v, __shfl_xor(v, o));
    return v;
}

__device__ __forceinline__ void p0_gemv_item(const Ptrs& P, int it, LAS unsigned char* lds, int tid) {
    const int ks = it / 32, ns = it % 32;
    LAS float* s_silu = (LAS float*)lds;
    LAS f32x4* red = (LAS f32x4*)(lds + 8192);
    if (tid < 256) {
#pragma unroll
        for (int b = 0; b < NBM; ++b) {
            const float v = (b < NB) ? P.c[b * DM + ks * 256 + tid] : P.c_ctx[ks * 256 + tid];
            s_silu[b * 256 + tid] = v / (1.0f + expf(-v));
        }
    }
    __syncthreads();
    if (tid < 384) {
        const int col4 = tid % 96, ksub = tid / 96;
        f32x4 acc[NBM];
#pragma unroll
        for (int b = 0; b < NBM; ++b) acc[b] = (f32x4){0.f, 0.f, 0.f, 0.f};
        const float* wp = P.w_ada + (size_t)(ks * 256 + ksub * 64) * NMOD + ns * 384 + col4 * 4;
#pragma unroll 8
        for (int kk = 0; kk < 64; ++kk) {
            const f32x4 w = *(const f32x4*)(wp + (size_t)kk * NMOD);
#pragma unroll
            for (int b = 0; b < NBM; ++b) acc[b] += w * s_silu[b * 256 + ksub * 64 + kk];
        }
#pragma unroll
        for (int b = 0; b < NBM; ++b) red[(ksub * NBM + b) * 96 + col4] = acc[b];
    }
    __syncthreads();
    if (tid < NBM * 96) {
        const int b = tid / 96, c4 = tid % 96;
        f32x4 s = red[(0 * NBM + b) * 96 + c4];
        s += red[(1 * NBM + b) * 96 + c4]; s += red[(2 * NBM + b) * 96 + c4]; s += red[(3 * NBM + b) * 96 + c4];
        float* modp = (float*)(P.ws + WS_MODP);
        *(f32x4*)(modp + ((size_t)ks * NBM + b) * NMOD + ns * 384 + c4 * 4) = s;
    }
    __syncthreads();
}
__device__ __forceinline__ void p0_transpose_item(const float* W, int K, int N, bf16_t* WT, int k0, int n0, int drow0, LAS float* scr, int lane) {
#pragma unroll 8
    for (int i = 0; i < 32; ++i) { const int kk = 2 * i + (lane >> 5); scr[kk * 33 + (lane & 31)] = W[(size_t)(k0 + kk) * N + n0 + (lane & 31)]; }
    asm volatile("s_waitcnt lgkmcnt(0)" ::: "memory");
    const int c = lane & 7;
#pragma unroll
    for (int j = 0; j < 4; ++j) { const int n = (lane >> 3) + 8 * j; const LAS float* s = scr + (8 * c) * 33 + n;
        u32x4 o; o.x = pk2(s[0 * 33], s[1 * 33]); o.y = pk2(s[2 * 33], s[3 * 33]); o.z = pk2(s[4 * 33], s[5 * 33]); o.w = pk2(s[6 * 33], s[7 * 33]);
        *(u32x4*)(WT + (size_t)(drow0 + n) * K + k0 + 8 * c) = o; }
    asm volatile("s_waitcnt lgkmcnt(0)" ::: "memory");
}
__device__ __forceinline__ void p0_prologue(const Ptrs& P, int bid, int G, LAS unsigned char* lds) {
    const int tid = threadIdx.x, lane = tid & 63, wave = tid >> 6;
    for (int it = bid; it < KSLAB * 32; it += G) p0_gemv_item(P, it, lds, tid);
    if (bid == 0) {
        float* rope = (float*)(P.ws + WS_ROPE);
        for (int idx = tid; idx < 64 * 16; idx += 512) {
            const int pos = idx / 16, i = idx % 16;
            const float inv = powf(10000.0f, -(float)i / 16.0f);
            const float ang = (float)pos * inv;
            rope[idx] = cosf(ang); rope[1024 + idx] = sinf(ang);
        }
        if (wave == 0) {
            const float s1 = wave_sum(P.lq1[lane] * P.lk1[lane]), s2 = wave_sum(P.lq2[lane] * P.lk2[lane]);
            if (lane == 0) rope[2048] = expf(s1) - expf(s2) + LAMBDA_INIT;
        }
    }
    __syncthreads();
    LAS float* scr = (LAS float*)(lds + wave * 16384);
    const int gw = bid * 8 + wave, NGW = G * 8;
    constexpr int I_IN = (DM / 64) * (NIN / 32), I_OUT = (DM / 64) * (DM / 32), I_GU = (DM / 64) * (2 * DFF / 32), I_DN = (DFF / 64) * (DM / 32), I_PL = 4 * (256 / 64) * (256 / 32);
    constexpr int NITEMS = I_IN + I_OUT + I_GU + I_DN + I_PL;
    for (int it = gw; it < NITEMS; it += NGW) {
        int r = it;
        if (r < I_IN) { const int nblk = NIN / 32, kb = r / nblk, nb = r % nblk; p0_transpose_item(P.w_in, DM, NIN, (bf16_t*)(P.ws + WS_WIN), 64 * kb, 32 * nb, 32 * nb, scr, lane); continue; } r -= I_IN;
        if (r < I_OUT) { const int nblk = DM / 32, kb = r / nblk, nb = r % nblk; p0_transpose_item(P.w_out, DM, DM, (bf16_t*)(P.ws + WS_WOUT), 64 * kb, 32 * nb, 32 * nb, scr, lane); continue; } r -= I_OUT;
        if (r < I_GU) { const int nblk = 2 * DFF / 32, kb = r / nblk, nb = r % nblk; const int n0 = 32 * nb, bj = n0 / DFF, rem = n0 % DFF, pn = rem / 128, cl = rem % 128;
            p0_transpose_item(P.w_gu, DM, 2 * DFF, (bf16_t*)(P.ws + WS_WGU), 64 * kb, n0, 256 * pn + 128 * bj + cl, scr, lane); continue; } r -= I_GU;
        if (r < I_DN) { const int nblk = DM / 32, kb = r / nblk, nb = r % nblk; p0_transpose_item(P.w_dn, DFF, DM, (bf16_t*)(P.ws + WS_WDN), 64 * kb, 32 * nb, 32 * nb, scr, lane); continue; } r -= I_DN;
        { const int g = r / 32, rr = r % 32, kb = rr / 8, nb = rr % 8; p0_transpose_item(P.w_pool + (size_t)g * 65536, 256, 256, (bf16_t*)(P.ws + WS_WPOOL) + (size_t)g * 65536, 64 * kb, 32 * nb, 32 * nb, scr, lane); }
    }
}

__device__ __forceinline__ void row_modnorm(const float* xrow, bf16_t* orow, const LAS float* a, const LAS float* s, int lane) {
    f32x4 v[8]; float ss = 0.f;
#pragma unroll
    for (int j = 0; j < 8; ++j) { v[j] = *((const f32x4*)xrow + lane + 64 * j); ss += (v[j].x * v[j].x + v[j].y * v[j].y) + (v[j].z * v[j].z + v[j].w * v[j].w); }
    const float inv = 1.0f / sqrtf(wave_sum(ss) * (1.0f / DM) + EPS);
#pragma unroll
    for (int j = 0; j < 8; ++j) { const f32x4 av = *((const LAS f32x4*)a + lane + 64 * j), sv = *((const LAS f32x4*)s + lane + 64 * j);
        const f32x4 y = v[j] * inv * av + sv; u32x2 o; o.x = pk2(y.x, y.y); o.y = pk2(y.z, y.w); *((u32x2*)orow + lane + 64 * j) = o; }
}
__device__ __forceinline__ void p1_rows(const Ptrs& P, int bid, int G, LAS unsigned char* lds) {
    const int tid = threadIdx.x, lane = tid & 63, wave = tid >> 6;
    const float* modp = (const float*)(P.ws + WS_MODP); float* mod = (float*)(P.ws + WS_MOD);
    for (int e = bid * 512 + tid; e < NBM * NMOD; e += G * 512) { float s = P.b_ada[e % NMOD];
#pragma unroll
        for (int k = 0; k < KSLAB; ++k) s += modp[(size_t)k * NBM * NMOD + e];
        mod[e] = s; }
    LAS float* la = (LAS float*)lds; LAS float* ls = (LAS float*)(lds + 8192);
    bf16_t* H = (bf16_t*)(P.ws + WS_H);
    for (int rb = bid; rb < 256 + 256; rb += G) {
        const bool isctx = rb >= 256; const int b = isctx ? NB : rb / 64;
        __syncthreads();
        for (int k = tid; k < DM; k += 512) { float sh = P.b_ada[k], sc = P.b_ada[DM + k];
#pragma unroll
            for (int s = 0; s < KSLAB; ++s) { sh += modp[((size_t)s * NBM + b) * NMOD + k]; sc += modp[((size_t)s * NBM + b) * NMOD + DM + k]; }
            la[k] = P.g_pre_mix[k] * (1.0f + sc); ls[k] = sh; }
        __syncthreads();
        if (!isctx) { for (int i = 0; i < 4; ++i) { const int row = rb * 32 + wave * 4 + i; row_modnorm(P.x + (size_t)row * DM, H + (size_t)row * DM, la, ls, lane); } }
        else if (wave < 4) { const int row = (rb - 256) * 4 + wave; row_modnorm(P.ctx + (size_t)row * DM, H + (size_t)(MLAT + row) * DM, la, ls, lane); }
    }
}
__device__ __forceinline__ void p6_rows(const Ptrs& P, int bid, int G, LAS unsigned char* lds) {
    const int tid = threadIdx.x, lane = tid & 63, wave = tid >> 6;
    const float* mod = (const float*)(P.ws + WS_MOD); const float* MIX = (const float*)(P.ws + WS_MIX);
    LAS float* lg = (LAS float*)lds; LAS float* la = (LAS float*)(lds + 8192); LAS float* ls = (LAS float*)(lds + 16384);
    bf16_t* H = (bf16_t*)(P.ws + WS_H);
    for (int rb = bid; rb < 256; rb += G) {
        const int b = rb / 64;
        __syncthreads();
        for (int k = tid; k < DM; k += 512) { lg[k] = mod[b * NMOD + 2 * DM + k] * P.g_post_mix[k]; la[k] = P.g_pre_ffn[k] * (1.0f + mod[b * NMOD + 4 * DM + k]); ls[k] = mod[b * NMOD + 3 * DM + k]; }
        __syncthreads();
        for (int i = 0; i < 4; ++i) {
            const int row = rb * 32 + wave * 4 + i;
            const float* mrow = MIX + (size_t)row * DM; const float* xrow = P.x + (size_t)row * DM; float* orow = P.out + (size_t)row * DM;
            f32x4 v[8]; float ss = 0.f;
#pragma unroll
            for (int j = 0; j < 8; ++j) { v[j] = *((const f32x4*)mrow + lane + 64 * j); ss += (v[j].x * v[j].x + v[j].y * v[j].y) + (v[j].z * v[j].z + v[j].w * v[j].w); }
            const float inv = 1.0f / sqrtf(wave_sum(ss) * (1.0f / DM) + EPS); float s2 = 0.f;
#pragma unroll
            for (int j = 0; j < 8; ++j) { const f32x4 xv = *((const f32x4*)xrow + lane + 64 * j), gv = *((const LAS f32x4*)lg + lane + 64 * j);
                v[j] = xv + v[j] * inv * gv; *((f32x4*)orow + lane + 64 * j) = v[j]; s2 += (v[j].x * v[j].x + v[j].y * v[j].y) + (v[j].z * v[j].z + v[j].w * v[j].w); }
            const float inv2 = 1.0f / sqrtf(wave_sum(s2) * (1.0f / DM) + EPS);
#pragma unroll
            for (int j = 0; j < 8; ++j) { const f32x4 av = *((const LAS f32x4*)la + lane + 64 * j), sv = *((const LAS f32x4*)ls + lane + 64 * j);
                const f32x4 y = v[j] * inv2 * av + sv; u32x2 o; o.x = pk2(y.x, y.y); o.y = pk2(y.z, y.w); *((u32x2*)(H + (size_t)row * DM) + lane + 64 * j) = o; }
        }
    }
}
__device__ __forceinline__ void p9_rows(const Ptrs& P, int bid, int G, LAS unsigned char* lds) {
    const int tid = threadIdx.x, lane = tid & 63, wave = tid >> 6;
    const float* mod = (const float*)(P.ws + WS_MOD); const float* FFN = (const float*)(P.ws + WS_MIX);
    LAS float* lg = (LAS float*)lds;
    for (int rb = bid; rb < 256; rb += G) {
        const int b = rb / 64;
        __syncthreads();
        for (int k = tid; k < DM; k += 512) lg[k] = mod[b * NMOD + 5 * DM + k] * P.g_post_ffn[k];
        __syncthreads();
        for (int i = 0; i < 4; ++i) {
            const int row = rb * 32 + wave * 4 + i;
            const float* frow = FFN + (size_t)row * DM; float* orow = P.out + (size_t)row * DM;
            f32x4 v[8]; float ss = 0.f;
#pragma unroll
            for (int j = 0; j < 8; ++j) { v[j] = *((const f32x4*)frow + lane + 64 * j); ss += (v[j].x * v[j].x + v[j].y * v[j].y) + (v[j].z * v[j].z + v[j].w * v[j].w); }
            const float inv = 1.0f / sqrtf(wave_sum(ss) * (1.0f / DM) + EPS);
#pragma unroll
            for (int j = 0; j < 8; ++j) { const f32x4 xv = *((const f32x4*)orow + lane + 64 * j), gv = *((const LAS f32x4*)lg + lane + 64 * j);
                *((f32x4*)orow + lane + 64 * j) = xv + v[j] * inv * gv; }
        }
    }
}
__device__ __forceinline__ void p3_dp(const Ptrs& P, int bid, int G) {
    const int tid = threadIdx.x; const bf16_t* Pp = (const bf16_t*)(P.ws + WS_P); bf16_t* Dp = (bf16_t*)(P.ws + WS_DP);
    for (int rb = bid; rb < 256; rb += G) {
        const int cg = tid & 127, run = tid >> 7, grp = cg >> 5, hw = 1 << grp;
        const int t0 = rb * 32 + run * 8, b = t0 / SEQ, tl0 = t0 % SEQ;
        const bf16_t* base = Pp + (size_t)b * SEQ * POOLW + cg * 8;
        float sum[8];
#pragma unroll
        for (int e = 0; e < 8; ++e) sum[e] = 0.f;
        { const int lo = max(tl0 - hw, 0), hi = min(tl0 + hw, SEQ);
          for (int r = lo; r < hi; ++r) { const bf16x8 v = *(const bf16x8*)(base + (size_t)r * POOLW);
#pragma unroll
              for (int e = 0; e < 8; ++e) sum[e] += bf2f((unsigned short)v[e]); } }
        for (int i = 0; i < 8; ++i) {
            const int tl = tl0 + i; const int lo = max(tl - hw, 0), hi = min(tl + hw, SEQ); const float rc = 1.0f / (float)(hi - lo);
            const bf16x8 pv = *(const bf16x8*)(base + (size_t)tl * POOLW);
            u32x4 o; float d[8];
#pragma unroll
            for (int e = 0; e < 8; ++e) d[e] = sum[e] * rc - bf2f((unsigned short)pv[e]);
            o.x = pk2(d[0], d[1]); o.y = pk2(d[2], d[3]); o.z = pk2(d[4], d[5]); o.w = pk2(d[6], d[7]);
            *(u32x4*)(Dp + (size_t)(t0 + i) * POOLW + cg * 8) = o;
            if (i < 7) {
                if (tl + hw < SEQ) { const bf16x8 v = *(const bf16x8*)(base + (size_t)(tl + hw) * POOLW);
#pragma unroll
                    for (int e = 0; e < 8; ++e) sum[e] += bf2f((unsigned short)v[e]); }
                if (tl - hw >= 0) { const bf16x8 v = *(const bf16x8*)(base + (size_t)(tl - hw) * POOLW);
#pragma unroll
                    for (int e = 0; e < 8; ++e) sum[e] -= bf2f((unsigned short)v[e]); }
            }
        }
    }
}

__global__ void __launch_bounds__(512) k_p0(Ptrs P) { extern __shared__ __attribute__((aligned(16))) unsigned char lds[]; p0_prologue(P, blockIdx.x, gridDim.x, (LAS unsigned char*)lds); }
__global__ void __launch_bounds__(512) k_p1(Ptrs P) { extern __shared__ __attribute__((aligned(16))) unsigned char lds[]; p1_rows(P, blockIdx.x, gridDim.x, (LAS unsigned char*)lds); }
__global__ void __launch_bounds__(512) k_dp(Ptrs P) { p3_dp(P, blockIdx.x, gridDim.x); }
__global__ void __launch_bounds__(512) k_p6(Ptrs P) { extern __shared__ __attribute__((aligned(16))) unsigned char lds[]; p6_rows(P, blockIdx.x, gridDim.x, (LAS unsigned char*)lds); }
__global__ void __launch_bounds__(512) k_p9(Ptrs P) { extern __shared__ __attribute__((aligned(16))) unsigned char lds[]; p9_rows(P, blockIdx.x, gridDim.x, (LAS unsigned char*)lds); }

struct EpiInproj {
    bf16_t *Pb, *Q, *K, *V; const float* rope;
    __device__ __forceinline__ void operator()(int row, int col, float v0, float v1) const {
        const int region = col >> 10, cc = col & 1023;
        if (row < MLAT) {
            const int b = row / SEQ, t = row % SEQ; const size_t krow = (size_t)b * KVL + CTXL + t;
            if (region == 0) { Pb[(size_t)row * POOLW + cc] = (bf16_t)f2bf(v0); Pb[(size_t)row * POOLW + cc + 16] = (bf16_t)f2bf(v1); }
            else if (region == 3) { V[krow * ATTW + cc] = (bf16_t)f2bf(v0); V[krow * ATTW + cc + 16] = (bf16_t)f2bf(v1); }
            else {
                const int within = cc & 63, half = within >> 5, i = within & 31;
                const int pos = half ? (t & 63) : (t >> 6);
                const float cs = rope[pos * 16 + i], sn = rope[1024 + pos * 16 + i];
                float o0 = v0 * cs - v1 * sn, o1 = v0 * sn + v1 * cs;
                if (region == 1) { o0 *= QSCALE; o1 *= QSCALE; Q[(size_t)row * ATTW + cc] = (bf16_t)f2bf(o0); Q[(size_t)row * ATTW + cc + 16] = (bf16_t)f2bf(o1); }
                else { K[krow * ATTW + cc] = (bf16_t)f2bf(o0); K[krow * ATTW + cc + 16] = (bf16_t)f2bf(o1); }
            }
        } else {
            const int r = row - MLAT, b = r / CTXL, j = r % CTXL; const size_t krow = (size_t)b * KVL + j;
            if (region == 2) { K[krow * ATTW + cc] = (bf16_t)f2bf(v0); K[krow * ATTW + cc + 16] = (bf16_t)f2bf(v1); }
            else if (region == 3) { V[krow * ATTW + cc] = (bf16_t)f2bf(v0); V[krow * ATTW + cc + 16] = (bf16_t)f2bf(v1); }
        }
    }
};
struct EpiPool {
    bf16_t* MIXIN; const float* pool_scale;
    __device__ __forceinline__ void operator()(int row, int col, float v0, float v1) const {
        MIXIN[(size_t)row * DM + col] = (bf16_t)f2bf(v0 * pool_scale[col]); MIXIN[(size_t)row * DM + col + 16] = (bf16_t)f2bf(v1 * pool_scale[col + 16]); }
};
struct EpiF32 {
    float* C; int ldc;
    __device__ __forceinline__ void operator()(int row, int col, float v0, float v1) const { C[(size_t)row * ldc + col] = v0; C[(size_t)row * ldc + col + 16] = v1; }
};
struct EpiSwiglu {
    bf16_t* ACT;
    __device__ __forceinline__ void operator()(int row, int col, float g, float u) const {
        ACT[(size_t)row * DFF + col] = (bf16_t)f2bf(g / (1.0f + expf(-g)) * u); }
};
template <class Epi, bool DUAL>
__global__ void __launch_bounds__(256) k_sgemm(const bf16_t* A, int lda, const bf16_t* Bt, int ldb, int K, Epi E, int erow_off, int ecol_off) {
    const int tid = threadIdx.x, wave = tid >> 6, lane = tid & 63, fr = lane & 15, fq = lane >> 4;
    const int row0 = blockIdx.y * 64 + wave * 16, col0 = blockIdx.x * 64;
    f32x4 acc[4], acc2[4];
#pragma unroll
    for (int n = 0; n < 4; ++n) { acc[n] = (f32x4){0.f, 0.f, 0.f, 0.f}; acc2[n] = (f32x4){0.f, 0.f, 0.f, 0.f}; }
    const bf16_t* ap = A + (size_t)(row0 + fr) * lda + 8 * fq;
    const int brow0 = DUAL ? (256 * (col0 / 128) + (col0 % 128)) : col0;
    const bf16_t* bp = Bt + (size_t)(brow0 + fr) * ldb + 8 * fq;
    for (int k0 = 0; k0 < K; k0 += 32) {
        const bf16x8 a = *(const bf16x8*)(ap + k0);
#pragma unroll
        for (int n = 0; n < 4; ++n) {
            const bf16x8 b = *(const bf16x8*)(bp + (size_t)(16 * n) * ldb + k0);
            acc[n] = __builtin_amdgcn_mfma_f32_16x16x32_bf16(a, b, acc[n], 0, 0, 0);
            if (DUAL) { const bf16x8 b2 = *(const bf16x8*)(bp + (size_t)(128 + 16 * n) * ldb + k0); acc2[n] = __builtin_amdgcn_mfma_f32_16x16x32_bf16(a, b2, acc2[n], 0, 0, 0); }
        }
    }
#pragma unroll
    for (int i = 0; i < 4; ++i) {
        const int row = erow_off + row0 + 4 * fq + i;
        if (DUAL) {
#pragma unroll
            for (int n = 0; n < 4; ++n) E(row, ecol_off + col0 + 16 * n + fr, acc[n][i], acc2[n][i]);
        } else {
            E(row, ecol_off + col0 + fr, acc[0][i], acc[1][i]);
            E(row, ecol_off + col0 + 32 + fr, acc[2][i], acc[3][i]);
        }
    }
}
__global__ void __launch_bounds__(256) k_sattn(Ptrs P) {
    __shared__ float sc[4][KVL];
    const int tid = threadIdx.x, wave = tid >> 6, lane = tid & 63;
    const int row = blockIdx.x * 4 + wave, h = blockIdx.y, b = row / SEQ;
    const bf16_t* Q = (const bf16_t*)(P.ws + WS_Q); const bf16_t* Kb = (const bf16_t*)(P.ws + WS_K) + (size_t)b * KVL * ATTW + h * VHD;
    const bf16_t* Vb = (const bf16_t*)(P.ws + WS_V) + (size_t)b * KVL * ATTW + h * VHD;
    const float lam = ((const float*)(P.ws + WS_ROPE))[2048];
    float o[2][2];
    for (int map = 0; map < 2; ++map) {
        float q[64];
#pragma unroll
        for (int d8 = 0; d8 < 8; ++d8) { const bf16x8 v = *(const bf16x8*)(Q + (size_t)row * ATTW + h * VHD + map * 64 + d8 * 8);
#pragma unroll
            for (int e = 0; e < 8; ++e) q[d8 * 8 + e] = bf2f((unsigned short)v[e]); }
        float mx = -1e30f;
        for (int i = 0; i < KVL / 64; ++i) { const int key = lane + 64 * i; const bf16_t* kp = Kb + (size_t)key * ATTW + map * 64; float s = 0.f;
#pragma unroll
            for (int d8 = 0; d8 < 8; ++d8) { const bf16x8 v = *(const bf16x8*)(kp + d8 * 8);
#pragma unroll
                for (int e = 0; e < 8; ++e) s += q[d8 * 8 + e] * bf2f((unsigned short)v[e]); }
            sc[wave][key] = s; mx = fmaxf(mx, s); }
        mx = wave_max(mx); float l = 0.f;
        for (int i = 0; i < KVL / 64; ++i) { const int key = lane + 64 * i; const float p = exp2f(sc[wave][key] - mx); sc[wave][key] = p; l += p; }
        l = wave_sum(l);
        __syncthreads();
        float a0 = 0.f, a1 = 0.f;
        for (int key = 0; key < KVL; ++key) { const float p = sc[wave][key]; const unsigned vv = *(const unsigned*)(Vb + (size_t)key * ATTW + 2 * lane);
            a0 += p * bf2f((unsigned short)(vv & 0xffffu)); a1 += p * bf2f((unsigned short)(vv >> 16)); }
        o[map][0] = a0 / l; o[map][1] = a1 / l;
    }
    const float d0 = o[0][0] - lam * o[1][0], d1 = o[0][1] - lam * o[1][1];
    const float ss = wave_sum(d0 * d0 + d1 * d1);
    const float inv = 1.0f / sqrtf(ss * (1.0f / VHD) + EPS) * (1.0f - LAMBDA_INIT);
    bf16_t* MIXIN = (bf16_t*)(P.ws + WS_MIXIN);
    *(unsigned*)(MIXIN + (size_t)row * DM + POOLW + h * VHD + 2 * lane) = pk2(d0 * inv * P.g_subln[2 * lane], d1 * inv * P.g_subln[2 * lane + 1]);
}

extern "C" void kernel_launch(void* const* d_in, const int* in_sizes, int n_in, void* d_out, int out_size, void* d_ws, size_t ws_size, hipStream_t stream) {
    static int ok = 0;
    if (ok == 0) {
        if (n_in != 21 || in_sizes[0] != MLAT * DM || out_size != MLAT * DM || ws_size < WS_END) {
            fprintf(stderr, "kernel_launch: unexpected shapes: n_in %d in0 %d out %d ws %zu (need >= %zu)\n", n_in, n_in > 0 ? in_sizes[0] : -1, out_size, ws_size, (size_t)WS_END); ok = -1; return; }
        if (hipFuncSetAttribute((const void*)k_p0, hipFuncAttributeMaxDynamicSharedMemorySize, 131072) != hipSuccess) { fprintf(stderr, "kernel_launch: hipFuncSetAttribute failed\n"); ok = -1; return; }
        ok = 1;
    }
    if (ok < 0) return;
    Ptrs P{};
#define IN_(i) ((const float*)d_in[i])
    P.x = IN_(0); P.c = IN_(1); P.ctx = IN_(2); P.c_ctx = IN_(3); P.w_ada = IN_(4); P.b_ada = IN_(5); P.g_pre_mix = IN_(6); P.g_post_mix = IN_(7);
    P.g_pre_ffn = IN_(8); P.g_post_ffn = IN_(9); P.w_in = IN_(10); P.w_pool = IN_(11); P.pool_scale = IN_(12); P.lq1 = IN_(13); P.lk1 = IN_(14);
    P.lq2 = IN_(15); P.lk2 = IN_(16); P.g_subln = IN_(17); P.w_out = IN_(18); P.w_gu = IN_(19); P.w_dn = IN_(20);
#undef IN_
    P.out = (float*)d_out; P.ws = (unsigned char*)d_ws;
    unsigned char* ws = (unsigned char*)d_ws;
    bf16_t* H = (bf16_t*)(ws + WS_H);
    hipLaunchKernelGGL(k_p0, dim3(256), dim3(512), 131072, stream, P);
    hipLaunchKernelGGL(k_p1, dim3(256), dim3(512), 16384, stream, P);
    EpiInproj ei{(bf16_t*)(ws + WS_P), (bf16_t*)(ws + WS_Q), (bf16_t*)(ws + WS_K), (bf16_t*)(ws + WS_V), (const float*)(ws + WS_ROPE)};
    hipLaunchKernelGGL((k_sgemm<EpiInproj, false>), dim3(NIN / 64, MLAT / 64), dim3(256), 0, stream, H, DM, (const bf16_t*)(ws + WS_WIN), DM, DM, ei, 0, 0);
    hipLaunchKernelGGL((k_sgemm<EpiInproj, false>), dim3(2048 / 64, MCTX / 64), dim3(256), 0, stream, H + (size_t)MLAT * DM, DM, (const bf16_t*)(ws + WS_WIN) + (size_t)2048 * DM, DM, DM, ei, MLAT, 2048);
    hipLaunchKernelGGL(k_dp, dim3(256), dim3(512), 0, stream, P);
    hipLaunchKernelGGL(k_sattn, dim3(MLAT / 4, NH), dim3(256), 0, stream, P);
    EpiPool ep{(bf16_t*)(ws + WS_MIXIN), P.pool_scale};
    for (int g = 0; g < 4; ++g)
        hipLaunchKernelGGL((k_sgemm<EpiPool, false>), dim3(256 / 64, MLAT / 64), dim3(256), 0, stream, (const bf16_t*)(ws + WS_DP) + g * 256, POOLW, (const bf16_t*)(ws + WS_WPOOL) + (size_t)g * 65536, 256, 256, ep, 0, g * 256);
    EpiF32 ef{(float*)(ws + WS_MIX), DM};
    hipLaunchKernelGGL((k_sgemm<EpiF32, false>), dim3(DM / 64, MLAT / 64), dim3(256), 0, stream, (const bf16_t*)(ws + WS_MIXIN), DM, (const bf16_t*)(ws + WS_WOUT), DM, DM, ef, 0, 0);
    hipLaunchKernelGGL(k_p6, dim3(256), dim3(512), 24576, stream, P);
    EpiSwiglu es{(bf16_t*)(ws + WS_ACT)};
    hipLaunchKernelGGL((k_sgemm<EpiSwiglu, true>), dim3(DFF / 64, MLAT / 64), dim3(256), 0, stream, H, DM, (const bf16_t*)(ws + WS_WGU), DM, DM, es, 0, 0);
    hipLaunchKernelGGL((k_sgemm<EpiF32, false>), dim3(DM / 64, MLAT / 64), dim3(256), 0, stream, (const bf16_t*)(ws + WS_ACT), DFF, (const bf16_t*)(ws + WS_WDN), DFF, DFF, ef, 0, 0);
    hipLaunchKernelGGL(k_p9, dim3(256), dim3(512), 8192, stream, P);
    const hipError_t le = hipPeekAtLastError();
    if (le != hipSuccess) fprintf(stderr, "kernel_launch: launch failed: %s\n", hipGetErrorName(le));
}
```

```cpp
#include <hip/hip_runtime.h>
#include <cstdio>
#include <cstdint>

#define GAS __attribute__((address_space(1)))
#define LAS __attribute__((address_space(3)))
typedef unsigned short bf16_t;
typedef short bf16x8 __attribute__((ext_vector_type(8)));
typedef float f32x4 __attribute__((ext_vector_type(4)));
typedef float f32x2 __attribute__((ext_vector_type(2)));
typedef unsigned u32x4 __attribute__((ext_vector_type(4)));
typedef unsigned u32x2 __attribute__((ext_vector_type(2)));

constexpr int DM = 2048, NB = 4, SEQ = 2048, CTXL = 256, MLAT = NB * SEQ, MCTX = NB * CTXL, MALL = MLAT + MCTX;
constexpr int NIN = 4096, POOLW = 1024, ATTW = 1024, NH = 8, VHD = 128, QKD = 64, DFF = 5632, NMOD = 6 * DM, KVL = CTXL + SEQ;
constexpr int NBM = NB + 1;
constexpr int KSLAB = 8;
constexpr float EPS = 1e-6f;
constexpr float QSCALE = 0.125f * 1.4426950408889634f;
constexpr float LAMBDA_INIT = 0.2f;

constexpr size_t MiB = 1u << 20;
constexpr size_t WS_CTL = 0, CTL_ZERO_BYTES = 1 * MiB;
constexpr size_t WS_MODP = 1 * MiB;
constexpr size_t WS_MOD = 3 * MiB;
constexpr size_t WS_ROPE = 3 * MiB + 512 * 1024;
constexpr size_t WS_WPOOL = 4 * MiB;
constexpr size_t WS_WIN = 8 * MiB;
constexpr size_t WS_WOUT = 24 * MiB;
constexpr size_t WS_WGU = 32 * MiB;
constexpr size_t WS_WDN = 76 * MiB;
constexpr size_t WS_H = 98 * MiB;
constexpr size_t WS_P = 134 * MiB;
constexpr size_t WS_Q = 150 * MiB;
constexpr size_t WS_K = 166 * MiB;
constexpr size_t WS_V = 184 * MiB;
constexpr size_t WS_DP = 202 * MiB;
constexpr size_t WS_MIXIN = 218 * MiB;
constexpr size_t WS_ACT = 134 * MiB;
constexpr size_t WS_MIX = 250 * MiB;
constexpr size_t WS_END = 314 * MiB;

struct Ptrs {
    const float *x, *c, *ctx, *c_ctx, *w_ada, *b_ada, *g_pre_mix, *g_post_mix, *g_pre_ffn, *g_post_ffn, *w_in, *w_pool, *pool_scale;
    const float *lq1, *lk1, *lq2, *lk2, *g_subln, *w_out, *w_gu, *w_dn;
    float* out; unsigned char* ws;
};

__device__ __forceinline__ unsigned f2bf(float f) { unsigned u = __builtin_bit_cast(unsigned, f); return (u + 0x7fffu + ((u >> 16) & 1u)) >> 16; }
__device__ __forceinline__ unsigned pk2(float lo, float hi) { return f2bf(lo) | (f2bf(hi) << 16); }
__device__ __forceinline__ float bf2f(unsigned short b) { return __builtin_bit_cast(float, (unsigned)b << 16); }
__device__ __forceinline__ float wave_sum(float v) {
#pragma unroll
    for (int o = 1; o < 64; o <<= 1) v += __shfl_xor(v, o);
    return v;
}
__device__ __forceinline__ float wave_max(float v) {
#pragma unroll
    for (int o = 1; o < 64; o <<= 1) v = fmaxf(v, __shfl_xor(v, o));
    return v;
}

__device__ __forceinline__ void p0_gemv_item(const Ptrs& P, int it, LAS unsigned char* lds, int tid) {
    const int ks = it / 32, ns = it % 32;
    LAS float* s_silu = (LAS float*)lds;
    LAS f32x4* red = (LAS f32x4*)(lds + 8192);
    if (tid < 256) {
#pragma unroll
        for (int b = 0; b < NBM; ++b) {
            const float v = (b < NB) ? P.c[b * DM + ks * 256 + tid] : P.c_ctx[ks * 256 + tid];
            s_silu[b * 256 + tid] = v / (1.0f + expf(-v));
        }
    }
    __syncthreads();
    if (tid < 384) {
        const int col4 = tid % 96, ksub = tid / 96;
        f32x4 acc[NBM];
#pragma unroll
        for (int b = 0; b < NBM; ++b) acc[b] = (f32x4){0.f, 0.f, 0.f, 0.f};
        const float* wp = P.w_ada + (size_t)(ks * 256 + ksub * 64) * NMOD + ns * 384 + col4 * 4;
#pragma unroll 8
        for (int kk = 0; kk < 64; ++kk) {
            const f32x4 w = *(const f32x4*)(wp + (size_t)kk * NMOD);
#pragma unroll
            for (int b = 0; b < NBM; ++b) acc[b] += w * s_silu[b * 256 + ksub * 64 + kk];
        }
#pragma unroll
        for (int b = 0; b < NBM; ++b) red[(ksub * NBM + b) * 96 + col4] = acc[b];
    }
    __syncthreads();
    if (tid < NBM * 96) {
        const int b = tid / 96, c4 = tid % 96;
        f32x4 s = red[(0 * NBM + b) * 96 + c4];
        s += red[(1 * NBM + b) * 96 + c4]; s += red[(2 * NBM + b) * 96 + c4]; s += red[(3 * NBM + b) * 96 + c4];
        float* modp = (float*)(P.ws + WS_MODP);
        *(f32x4*)(modp + ((size_t)ks * NBM + b) * NMOD + ns * 384 + c4 * 4) = s;
    }
    __syncthreads();
}
__device__ __forceinline__ void p0_transpose_item(const float* W, int K, int N, bf16_t* WT, int k0, int n0, int drow0, LAS float* scr, int lane) {
#pragma unroll 8
    for (int i = 0; i < 32; ++i) { const int kk = 2 * i + (lane >> 5); scr[kk * 33 + (lane & 31)] = W[(size_t)(k0 + kk) * N + n0 + (lane & 31)]; }
    asm volatile("s_waitcnt lgkmcnt(0)" ::: "memory");
    const int c = lane & 7;
#pragma unroll
    for (int j = 0; j < 4; ++j) { const int n = (lane >> 3) + 8 * j; const LAS float* s = scr + (8 * c) * 33 + n;
        u32x4 o; o.x = pk2(s[0 * 33], s[1 * 33]); o.y = pk2(s[2 * 33], s[3 * 33]); o.z = pk2(s[4 * 33], s[5 * 33]); o.w = pk2(s[6 * 33], s[7 * 33]);
        *(u32x4*)(WT + (size_t)(drow0 + n) * K + k0 + 8 * c) = o; }
    asm volatile("s_waitcnt lgkmcnt(0)" ::: "memory");
}
__device__ __forceinline__ void p0_prologue(const Ptrs& P, int bid, int G, LAS unsigned char* lds) {
    const int tid = threadIdx.x, lane = tid & 63, wave = tid >> 6;
    for (int it = bid; it < KSLAB * 32; it += G) p0_gemv_item(P, it, lds, tid);
    if (bid == 0) {
        float* rope = (float*)(P.ws + WS_ROPE);
        for (int idx = tid; idx < 64 * 16; idx += 512) {
            const int pos = idx / 16, i = idx % 16;
            const float inv = powf(10000.0f, -(float)i / 16.0f);
            const float ang = (float)pos * inv;
            rope[idx] = cosf(ang); rope[1024 + idx] = sinf(ang);
        }
        if (wave == 0) {
            const float s1 = wave_sum(P.lq1[lane] * P.lk1[lane]), s2 = wave_sum(P.lq2[lane] * P.lk2[lane]);
            if (lane == 0) rope[2048] = expf(s1) - expf(s2) + LAMBDA_INIT;
        }
    }
    __syncthreads();
    LAS float* scr = (LAS float*)(lds + wave * 16384);
    const int gw = bid * 8 + wave, NGW = G * 8;
    constexpr int I_IN = (DM / 64) * (NIN / 32), I_OUT = (DM / 64) * (DM / 32), I_GU = (DM / 64) * (2 * DFF / 32), I_DN = (DFF / 64) * (DM / 32), I_PL = 4 * (256 / 64) * (256 / 32);
    constexpr int NITEMS = I_IN + I_OUT + I_GU + I_DN + I_PL;
    for (int it = gw; it < NITEMS; it += NGW) {
        int r = it;
        if (r < I_IN) { const int nblk = NIN / 32, kb = r / nblk, nb = r % nblk; p0_transpose_item(P.w_in, DM, NIN, (bf16_t*)(P.ws + WS_WIN), 64 * kb, 32 * nb, 32 * nb, scr, lane); continue; } r -= I_IN;
        if (r < I_OUT) { const int nblk = DM / 32, kb = r / nblk, nb = r % nblk; p0_transpose_item(P.w_out, DM, DM, (bf16_t*)(P.ws + WS_WOUT), 64 * kb, 32 * nb, 32 * nb, scr, lane); continue; } r -= I_OUT;
        if (r < I_GU) { const int nblk = 2 * DFF / 32, kb = r / nblk, nb = r % nblk; const int n0 = 32 * nb, bj = n0 / DFF, rem = n0 % DFF, pn = rem / 128, cl = rem % 128;
            p0_transpose_item(P.w_gu, DM, 2 * DFF, (bf16_t*)(P.ws + WS_WGU), 64 * kb, n0, 256 * pn + 128 * bj + cl, scr, lane); continue; } r -= I_GU;
        if (r < I_DN) { const int nblk = DM / 32, kb = r / nblk, nb = r % nblk; p0_transpose_item(P.w_dn, DFF, DM, (bf16_t*)(P.ws + WS_WDN), 64 * kb, 32 * nb, 32 * nb, scr, lane); continue; } r -= I_DN;
        { const int g = r / 32, rr = r % 32, kb = rr / 8, nb = rr % 8; p0_transpose_item(P.w_pool + (size_t)g * 65536, 256, 256, (bf16_t*)(P.ws + WS_WPOOL) + (size_t)g * 65536, 64 * kb, 32 * nb, 32 * nb, scr, lane); }
    }
}

__device__ __forceinline__ void row_modnorm(const float* xrow, bf16_t* orow, const LAS float* a, const LAS float* s, int lane) {
    f32x4 v[8]; float ss = 0.f;
#pragma unroll
    for (int j = 0; j < 8; ++j) { v[j] = *((const f32x4*)xrow + lane + 64 * j); ss += (v[j].x * v[j].x + v[j].y * v[j].y) + (v[j].z * v[j].z + v[j].w * v[j].w); }
    const float inv = 1.0f / sqrtf(wave_sum(ss) * (1.0f / DM) + EPS);
#pragma unroll
    for (int j = 0; j < 8; ++j) { const f32x4 av = *((const LAS f32x4*)a + lane + 64 * j), sv = *((const LAS f32x4*)s + lane + 64 * j);
        const f32x4 y = v[j] * inv * av + sv; u32x2 o; o.x = pk2(y.x, y.y); o.y = pk2(y.z, y.w); *((u32x2*)orow + lane + 64 * j) = o; }
}
__device__ __forceinline__ void p1_rows(const Ptrs& P, int bid, int G, LAS unsigned char* lds) {
    const int tid = threadIdx.x, lane = tid & 63, wave = tid >> 6;
    const float* modp = (const float*)(P.ws + WS_MODP); float* mod = (float*)(P.ws + WS_MOD);
    for (int e = bid * 512 + tid; e < NBM * NMOD; e += G * 512) { float s = P.b_ada[e % NMOD];
#pragma unroll
        for (int k = 0; k < KSLAB; ++k) s += modp[(size_t)k * NBM * NMOD + e];
        mod[e] = s; }
    LAS float* la = (LAS float*)lds; LAS float* ls = (LAS float*)(lds + 8192);
    bf16_t* H = (bf16_t*)(P.ws + WS_H);
    for (int rb = bid; rb < 256 + 256; rb += G) {
        const bool isctx = rb >= 256; const int b = isctx ? NB : rb / 64;
        __syncthreads();
        for (int k = tid; k < DM; k += 512) { float sh = P.b_ada[k], sc = P.b_ada[DM + k];
#pragma unroll
            for (int s = 0; s < KSLAB; ++s) { sh += modp[((size_t)s * NBM + b) * NMOD + k]; sc += modp[((size_t)s * NBM + b) * NMOD + DM + k]; }
            la[k] = P.g_pre_mix[k] * (1.0f + sc); ls[k] = sh; }
        __syncthreads();
        if (!isctx) { for (int i = 0; i < 4; ++i) { const int row = rb * 32 + wave * 4 + i; row_modnorm(P.x + (size_t)row * DM, H + (size_t)row * DM, la, ls, lane); } }
        else if (wave < 4) { const int row = (rb - 256) * 4 + wave; row_modnorm(P.ctx + (size_t)row * DM, H + (size_t)(MLAT + row) * DM, la, ls, lane); }
    }
}
__device__ __forceinline__ void p6_rows(const Ptrs& P, int bid, int G, LAS unsigned char* lds) {
    const int tid = threadIdx.x, lane = tid & 63, wave = tid >> 6;
    const float* mod = (const float*)(P.ws + WS_MOD); const float* MIX = (const float*)(P.ws + WS_MIX);
    LAS float* lg = (LAS float*)lds; LAS float* la = (LAS float*)(lds + 8192); LAS float* ls = (LAS float*)(lds + 16384);
    bf16_t* H = (bf16_t*)(P.ws + WS_H);
    for (int rb = bid; rb < 256; rb += G) {
        const int b = rb / 64;
        __syncthreads();
        for (int k = tid; k < DM; k += 512) { lg[k] = mod[b * NMOD + 2 * DM + k] * P.g_post_mix[k]; la[k] = P.g_pre_ffn[k] * (1.0f + mod[b * NMOD + 4 * DM + k]); ls[k] = mod[b * NMOD + 3 * DM + k]; }
        __syncthreads();
        for (int i = 0; i < 4; ++i) {
            const int row = rb * 32 + wave * 4 + i;
            const float* mrow = MIX + (size_t)row * DM; const float* xrow = P.x + (size_t)row * DM; float* orow = P.out + (size_t)row * DM;
            f32x4 v[8]; float ss = 0.f;
#pragma unroll
            for (int j = 0; j < 8; ++j) { v[j] = *((const f32x4*)mrow + lane + 64 * j); ss += (v[j].x * v[j].x + v[j].y * v[j].y) + (v[j].z * v[j].z + v[j].w * v[j].w); }
            const float inv = 1.0f / sqrtf(wave_sum(ss) * (1.0f / DM) + EPS); float s2 = 0.f;
#pragma unroll
            for (int j = 0; j < 8; ++j) { const f32x4 xv = *((const f32x4*)xrow + lane + 64 * j), gv = *((const LAS f32x4*)lg + lane + 64 * j);
                v[j] = xv + v[j] * inv * gv; *((f32x4*)orow + lane + 64 * j) = v[j]; s2 += (v[j].x * v[j].x + v[j].y * v[j].y) + (v[j].z * v[j].z + v[j].w * v[j].w); }
            const float inv2 = 1.0f / sqrtf(wave_sum(s2) * (1.0f / DM) + EPS);
#pragma unroll
            for (int j = 0; j < 8; ++j) { const f32x4 av = *((const LAS f32x4*)la + lane + 64 * j), sv = *((const LAS f32x4*)ls + lane + 64 * j);
                const f32x4 y = v[j] * inv2 * av + sv; u32x2 o; o.x = pk2(y.x, y.y); o.y = pk2(y.z, y.w); *((u32x2*)(H + (size_t)row * DM) + lane + 64 * j) = o; }
        }
    }
}
__device__ __forceinline__ void p9_rows(const Ptrs& P, int bid, int G, LAS unsigned char* lds) {
    const int tid = threadIdx.x, lane = tid & 63, wave = tid >> 6;
    const float* mod = (const float*)(P.ws + WS_MOD); const float* FFN = (const float*)(P.ws + WS_MIX);
    LAS float* lg = (LAS float*)lds;
    for (int rb = bid; rb < 256; rb += G) {
        const int b = rb / 64;
        __syncthreads();
        for (int k = tid; k < DM; k += 512) lg[k] = mod[b * NMOD + 5 * DM + k] * P.g_post_ffn[k];
        __syncthreads();
        for (int i = 0; i < 4; ++i) {
            const int row = rb * 32 + wave * 4 + i;
            const float* frow = FFN + (size_t)row * DM; float* orow = P.out + (size_t)row * DM;
            f32x4 v[8]; float ss = 0.f;
#pragma unroll
            for (int j = 0; j < 8; ++j) { v[j] = *((const f32x4*)frow + lane + 64 * j); ss += (v[j].x * v[j].x + v[j].y * v[j].y) + (v[j].z * v[j].z + v[j].w * v[j].w); }
            const float inv = 1.0f / sqrtf(wave_sum(ss) * (1.0f / DM) + EPS);
#pragma unroll
            for (int j = 0; j < 8; ++j) { const f32x4 xv = *((const f32x4*)orow + lane + 64 * j), gv = *((const LAS f32x4*)lg + lane + 64 * j);
                *((f32x4*)orow + lane + 64 * j) = xv + v[j] * inv * gv; }
        }
    }
}
__device__ __forceinline__ void p3_dp(const Ptrs& P, int bid, int G) {
    const int tid = threadIdx.x; const bf16_t* Pp = (const bf16_t*)(P.ws + WS_P); bf16_t* Dp = (bf16_t*)(P.ws + WS_DP);
    for (int rb = bid; rb < 256; rb += G) {
        const int cg = tid & 127, run = tid >> 7, grp = cg >> 5, hw = 1 << grp;
        const int t0 = rb * 32 + run * 8, b = t0 / SEQ, tl0 = t0 % SEQ;
        const bf16_t* base = Pp + (size_t)b * SEQ * POOLW + cg * 8;
        float sum[8];
#pragma unroll
        for (int e = 0; e < 8; ++e) sum[e] = 0.f;
        { const int lo = max(tl0 - hw, 0), hi = min(tl0 + hw, SEQ);
          for (int r = lo; r < hi; ++r) { const bf16x8 v = *(const bf16x8*)(base + (size_t)r * POOLW);
#pragma unroll
              for (int e = 0; e < 8; ++e) sum[e] += bf2f((unsigned short)v[e]); } }
        for (int i = 0; i < 8; ++i) {
            const int tl = tl0 + i; const int lo = max(tl - hw, 0), hi = min(tl + hw, SEQ); const float rc = 1.0f / (float)(hi - lo);
            const bf16x8 pv = *(const bf16x8*)(base + (size_t)tl * POOLW);
            u32x4 o; float d[8];
#pragma unroll
            for (int e = 0; e < 8; ++e) d[e] = sum[e] * rc - bf2f((unsigned short)pv[e]);
            o.x = pk2(d[0], d[1]); o.y = pk2(d[2], d[3]); o.z = pk2(d[4], d[5]); o.w = pk2(d[6], d[7]);
            *(u32x4*)(Dp + (size_t)(t0 + i) * POOLW + cg * 8) = o;
            if (i < 7) {
                if (tl + hw < SEQ) { const bf16x8 v = *(const bf16x8*)(base + (size_t)(tl + hw) * POOLW);
#pragma unroll
                    for (int e = 0; e < 8; ++e) sum[e] += bf2f((unsigned short)v[e]); }
                if (tl - hw >= 0) { const bf16x8 v = *(const bf16x8*)(base + (size_t)(tl - hw) * POOLW);
#pragma unroll
                    for (int e = 0; e < 8; ++e) sum[e] -= bf2f((unsigned short)v[e]); }
            }
        }
    }
}

__global__ void __launch_bounds__(512) k_p0(Ptrs P) { extern __shared__ __attribute__((aligned(16))) unsigned char lds[]; p0_prologue(P, blockIdx.x, gridDim.x, (LAS unsigned char*)lds); }
__global__ void __launch_bounds__(512) k_p1(Ptrs P) { extern __shared__ __attribute__((aligned(16))) unsigned char lds[]; p1_rows(P, blockIdx.x, gridDim.x, (LAS unsigned char*)lds); }
__global__ void __launch_bounds__(512) k_dp(Ptrs P) { p3_dp(P, blockIdx.x, gridDim.x); }
__global__ void __launch_bounds__(512) k_p6(Ptrs P) { extern __shared__ __attribute__((aligned(16))) unsigned char lds[]; p6_rows(P, blockIdx.x, gridDim.x, (LAS unsigned char*)lds); }
__global__ void __launch_bounds__(512) k_p9(Ptrs P) { extern __shared__ __attribute__((aligned(16))) unsigned char lds[]; p9_rows(P, blockIdx.x, gridDim.x, (LAS unsigned char*)lds); }

struct EpiInproj {
    bf16_t *Pb, *Q, *K, *V; const float* rope;
    __device__ __forceinline__ void operator()(int row, int col, float v0, float v1) const {
        const int region = col >> 10, cc = col & 1023;
        if (row < MLAT) {
            const int b = row / SEQ, t = row % SEQ; const size_t krow = (size_t)b * KVL + CTXL + t;
            if (region == 0) { Pb[(size_t)row * POOLW + cc] = (bf16_t)f2bf(v0); Pb[(size_t)row * POOLW + cc + 16] = (bf16_t)f2bf(v1); }
            else if (region == 3) { V[krow * ATTW + cc] = (bf16_t)f2bf(v0); V[krow * ATTW + cc + 16] = (bf16_t)f2bf(v1); }
            else {
                const int within = cc & 63, half = within >> 5, i = within & 31;
                const int pos = half ? (t & 63) : (t >> 6);
                const float cs = rope[pos * 16 + i], sn = rope[1024 + pos * 16 + i];
                float o0 = v0 * cs - v1 * sn, o1 = v0 * sn + v1 * cs;
                if (region == 1) { o0 *= QSCALE; o1 *= QSCALE; Q[(size_t)row * ATTW + cc] = (bf16_t)f2bf(o0); Q[(size_t)row * ATTW + cc + 16] = (bf16_t)f2bf(o1); }
                else { K[krow * ATTW + cc] = (bf16_t)f2bf(o0); K[krow * ATTW + cc + 16] = (bf16_t)f2bf(o1); }
            }
        } else {
            const int r = row - MLAT, b = r / CTXL, j = r % CTXL; const size_t krow = (size_t)b * KVL + j;
            if (region == 2) { K[krow * ATTW + cc] = (bf16_t)f2bf(v0); K[krow * ATTW + cc + 16] = (bf16_t)f2bf(v1); }
            else if (region == 3) { V[krow * ATTW + cc] = (bf16_t)f2bf(v0); V[krow * ATTW + cc + 16] = (bf16_t)f2bf(v1); }
        }
    }
};
struct EpiPool {
    bf16_t* MIXIN; const float* pool_scale;
    __device__ __forceinline__ void operator()(int row, int col, float v0, float v1) const {
        MIXIN[(size_t)row * DM + col] = (bf16_t)f2bf(v0 * pool_scale[col]); MIXIN[(size_t)row * DM + col + 16] = (bf16_t)f2bf(v1 * pool_scale[col + 16]); }
};
struct EpiF32 {
    float* C; int ldc;
    __device__ __forceinline__ void operator()(int row, int col, float v0, float v1) const { C[(size_t)row * ldc + col] = v0; C[(size_t)row * ldc + col + 16] = v1; }
};
struct EpiSwiglu {
    bf16_t* ACT;
    __device__ __forceinline__ void operator()(int row, int col, float g, float u) const {
        ACT[(size_t)row * DFF + col] = (bf16_t)f2bf(g / (1.0f + expf(-g)) * u); }
};
template <class Epi, bool DUAL>
__global__ void __launch_bounds__(256) k_sgemm(const bf16_t* A, int lda, const bf16_t* Bt, int ldb, int K, Epi E, int erow_off, int ecol_off) {
    const int tid = threadIdx.x, wave = tid >> 6, lane = tid & 63, fr = lane & 15, fq = lane >> 4;
    const int row0 = blockIdx.y * 64 + wave * 16, col0 = blockIdx.x * 64;
    f32x4 acc[4], acc2[4];
#pragma unroll
    for (int n = 0; n < 4; ++n) { acc[n] = (f32x4){0.f, 0.f, 0.f, 0.f}; acc2[n] = (f32x4){0.f, 0.f, 0.f, 0.f}; }
    const bf16_t* ap = A + (size_t)(row0 + fr) * lda + 8 * fq;
    const int brow0 = DUAL ? (256 * (col0 / 128) + (col0 % 128)) : col0;
    const bf16_t* bp = Bt + (size_t)(brow0 + fr) * ldb + 8 * fq;
    for (int k0 = 0; k0 < K; k0 += 32) {
        const bf16x8 a = *(const bf16x8*)(ap + k0);
#pragma unroll
        for (int n = 0; n < 4; ++n) {
            const bf16x8 b = *(const bf16x8*)(bp + (size_t)(16 * n) * ldb + k0);
            acc[n] = __builtin_amdgcn_mfma_f32_16x16x32_bf16(a, b, acc[n], 0, 0, 0);
            if (DUAL) { const bf16x8 b2 = *(const bf16x8*)(bp + (size_t)(128 + 16 * n) * ldb + k0); acc2[n] = __builtin_amdgcn_mfma_f32_16x16x32_bf16(a, b2, acc2[n], 0, 0, 0); }
        }
    }
#pragma unroll
    for (int i = 0; i < 4; ++i) {
        const int row = erow_off + row0 + 4 * fq + i;
        if (DUAL) {
#pragma unroll
            for (int n = 0; n < 4; ++n) E(row, ecol_off + col0 + 16 * n + fr, acc[n][i], acc2[n][i]);
        } else {
            E(row, ecol_off + col0 + fr, acc[0][i], acc[1][i]);
            E(row, ecol_off + col0 + 32 + fr, acc[2][i], acc[3][i]);
        }
    }
}
__global__ void __launch_bounds__(256) k_sattn(Ptrs P) {
    __shared__ float sc[4][KVL];
    const int tid = threadIdx.x, wave = tid >> 6, lane = tid & 63;
    const int row = blockIdx.x * 4 + wave, h = blockIdx.y, b = row / SEQ;
    const bf16_t* Q = (const bf16_t*)(P.ws + WS_Q); const bf16_t* Kb = (const bf16_t*)(P.ws + WS_K) + (size_t)b * KVL * ATTW + h * VHD;
    const bf16_t* Vb = (const bf16_t*)(P.ws + WS_V) + (size_t)b * KVL * ATTW + h * VHD;
    const float lam = ((const float*)(P.ws + WS_ROPE))[2048];
    float o[2][2];
    for (int map = 0; map < 2; ++map) {
        float q[64];
#pragma unroll
        for (int d8 = 0; d8 < 8; ++d8) { const bf16x8 v = *(const bf16x8*)(Q + (size_t)row * ATTW + h * VHD + map * 64 + d8 * 8);
#pragma unroll
            for (int e = 0; e < 8; ++e) q[d8 * 8 + e] = bf2f((unsigned short)v[e]); }
        float mx = -1e30f;
        for (int i = 0; i < KVL / 64; ++i) { const int key = lane + 64 * i; const bf16_t* kp = Kb + (size_t)key * ATTW + map * 64; float s = 0.f;
#pragma unroll
            for (int d8 = 0; d8 < 8; ++d8) { const bf16x8 v = *(const bf16x8*)(kp + d8 * 8);
#pragma unroll
                for (int e = 0; e < 8; ++e) s += q[d8 * 8 + e] * bf2f((unsigned short)v[e]); }
            sc[wave][key] = s; mx = fmaxf(mx, s); }
        mx = wave_max(mx); float l = 0.f;
        for (int i = 0; i < KVL / 64; ++i) { const int key = lane + 64 * i; const float p = exp2f(sc[wave][key] - mx); sc[wave][key] = p; l += p; }
        l = wave_sum(l);
        __syncthreads();
        float a0 = 0.f, a1 = 0.f;
        for (int key = 0; key < KVL; ++key) { const float p = sc[wave][key]; const unsigned vv = *(const unsigned*)(Vb + (size_t)key * ATTW + 2 * lane);
            a0 += p * bf2f((unsigned short)(vv & 0xffffu)); a1 += p * bf2f((unsigned short)(vv >> 16)); }
        o[map][0] = a0 / l; o[map][1] = a1 / l;
    }
    const float d0 = o[0][0] - lam * o[1][0], d1 = o[0][1] - lam * o[1][1];
    const float ss = wave_sum(d0 * d0 + d1 * d1);
    const float inv = 1.0f / sqrtf(ss * (1.0f / VHD) + EPS) * (1.0f - LAMBDA_INIT);
    bf16_t* MIXIN = (bf16_t*)(P.ws + WS_MIXIN);
    *(unsigned*)(MIXIN + (size_t)row * DM + POOLW + h * VHD + 2 * lane) = pk2(d0 * inv * P.g_subln[2 * lane], d1 * inv * P.g_subln[2 * lane + 1]);
}

namespace pg8 {
constexpr int BM = 256, BK = 64, HALF = 128, HTB = HALF * BK * 2  , STAGE_BYTES = 8 * HTB, NXCD = 8, WGM = 8;
__host__ __device__ __forceinline__ int lds_byte(int r, int c) { const int st = (r >> 4) * 2 + (c >> 5), rr = r & 15, cc = c & 31, ob = rr * 64 + cc * 2; return st * 1024 + (ob ^ (((ob >> 9) & 1) << 5)); }
__host__ __device__ __forceinline__ void stage_rc(int b, int& R, int& C) { const int st = b / 1024, sb = b % 1024, swz = sb ^ (((sb >> 9) & 1) << 5); R = (st >> 1) * 16 + swz / 64; C = (st & 1) * 32 + (swz % 64) / 2; }
__host__ __device__ __forceinline__ int perm32(int rho) { const int n = rho >> 4, i = rho & 15; return 8 * (i >> 2) + 4 * n + (i & 3); }

struct Unit { int pm, pn; };
struct Gemm { const bf16_t* A; const bf16_t* Bt; int lda, ldb, K; };

__device__ __forceinline__ void std_unit(int L, int nM, int nN, Unit& u) {
    const int nwg = nM * nN; int wgid = L; { const int q = nwg / NXCD, r = nwg % NXCD, xcd = wgid % NXCD, off = wgid / NXCD; wgid = (xcd < r ? xcd * (q + 1) : r * (q + 1) + (xcd - r) * q) + off; }
    const int nig = WGM * nN, gid = wgid / nig, fm = gid * WGM, gsz = (nM - fm) < WGM ? (nM - fm) : WGM;
    u.pm = fm + ((wgid % nig) % gsz); u.pn = (wgid % nig) / gsz;
}
struct SchedStd {
    int nM, nN, G, c, lda, ldb;
    __device__ __forceinline__ bool next(int i, Unit& u) const { const int L = i * G + c; if (L >= nM * nN) return false; std_unit(L, nM, nN, u); return true; }
    __device__ __forceinline__ size_t aoff(const Unit& u) const { return (size_t)u.pm * 256 * lda * 2; }
    __device__ __forceinline__ size_t boff(const Unit& u) const { return (size_t)u.pn * 256 * ldb * 2; }
};
struct SchedInproj {
    int G, c;
    __device__ __forceinline__ bool next(int i, Unit& u) const { const int L = i * G + c; if (L >= 512 + 32) return false;
        if (L < 512) std_unit(L, 32, 16, u); else { const int j = L - 512; u.pm = 32 + (j >> 3); u.pn = 8 + (j & 7); } return true; }
    __device__ __forceinline__ size_t aoff(const Unit& u) const { return (size_t)u.pm * 256 * DM * 2; }
    __device__ __forceinline__ size_t boff(const Unit& u) const { return (size_t)u.pn * 256 * DM * 2; }
};
struct SchedPool {
    int G, c;
    __device__ __forceinline__ bool next(int i, Unit& u) const { const int L = i * G + c; if (L >= 128) return false; u.pm = L >> 2; u.pn = L & 3; return true; }
    __device__ __forceinline__ size_t aoff(const Unit& u) const { return ((size_t)u.pm * 256 * POOLW + (size_t)u.pn * 256) * 2; }
    __device__ __forceinline__ size_t boff(const Unit& u) const { return (size_t)u.pn * 65536 * 2; }
};

__device__ __forceinline__ u32x2 pk4(const f32x4 v) { u32x2 o; o.x = pk2(v[0], v[1]); o.y = pk2(v[2], v[3]); return o; }
struct EpiInprojF {
    static constexpr bool PERM = false;
    bf16_t *Pb, *Q, *K, *V; const float* rope;
    __device__ __forceinline__ void operator()(const f32x4 (&acc)[2][2][4][2], const Unit& u, int wr, int wc, int fr, int fq) const {
        const int region = u.pn >> 2, cbase = (u.pn & 3) * 256 + wc * 32 + 4 * fq;
        const bool lat = u.pm < 32;
#pragma unroll
        for (int ai = 0; ai < 2; ++ai)
#pragma unroll
            for (int m = 0; m < 4; ++m) {
                const int lr = 128 * ai + 64 * wr + 16 * m + fr;
                const int b = lat ? (u.pm >> 3) : (u.pm - 32), t = (u.pm & 7) * 256 + lr;
                const size_t grow = (size_t)u.pm * 256 + lr, krow = lat ? ((size_t)b * KVL + CTXL + t) : ((size_t)b * KVL + lr);
                if (region == 0) {
#pragma unroll
                    for (int bj = 0; bj < 2; ++bj)
#pragma unroll
                        for (int n = 0; n < 2; ++n) *(u32x2*)(Pb + grow * POOLW + cbase + 128 * bj + 16 * n) = pk4(acc[ai][bj][m][n]);
                } else if (region == 3) {
#pragma unroll
                    for (int bj = 0; bj < 2; ++bj)
#pragma unroll
                        for (int n = 0; n < 2; ++n) *(u32x2*)(V + krow * ATTW + cbase + 128 * bj + 16 * n) = pk4(acc[ai][bj][m][n]);
                } else if (!lat) {
#pragma unroll
                    for (int bj = 0; bj < 2; ++bj)
#pragma unroll
                        for (int n = 0; n < 2; ++n) *(u32x2*)(K + krow * ATTW + cbase + 128 * bj + 16 * n) = pk4(acc[ai][bj][m][n]);
                } else {
                    const int pos = (wc & 1) ? (t & 63) : (t >> 6);
                    const f32x4 cs = *(const f32x4*)(rope + pos * 16 + 4 * fq), sn = *(const f32x4*)(rope + 1024 + pos * 16 + 4 * fq);
#pragma unroll
                    for (int bj = 0; bj < 2; ++bj) {
                        const f32x4 x1 = acc[ai][bj][m][0], x2 = acc[ai][bj][m][1];
                        f32x4 o1 = x1 * cs - x2 * sn, o2 = x1 * sn + x2 * cs;
                        if (region == 1) { o1 = o1 * QSCALE; o2 = o2 * QSCALE;
                            *(u32x2*)(Q + grow * ATTW + cbase + 128 * bj) = pk4(o1); *(u32x2*)(Q + grow * ATTW + cbase + 128 * bj + 16) = pk4(o2); }
                        else { *(u32x2*)(K + krow * ATTW + cbase + 128 * bj) = pk4(o1); *(u32x2*)(K + krow * ATTW + cbase + 128 * bj + 16) = pk4(o2); }
                    }
                }
            }
    }
};
struct EpiPoolF {
    static constexpr bool PERM = true;
    bf16_t* MIXIN; const float* pool_scale;
    __device__ __forceinline__ void operator()(const f32x4 (&acc)[2][2][4][2], const Unit& u, int wr, int wc, int fr, int fq) const {
        const int col0 = u.pn * 256 + wc * 32 + 8 * fq;
        f32x4 sv[2][2];
#pragma unroll
        for (int bj = 0; bj < 2; ++bj)
#pragma unroll
            for (int n = 0; n < 2; ++n) sv[bj][n] = *(const f32x4*)(pool_scale + col0 + bj * HALF + 4 * n);
#pragma unroll
        for (int ai = 0; ai < 2; ++ai)
#pragma unroll
            for (int m = 0; m < 4; ++m) { bf16_t* rowp = MIXIN + ((size_t)u.pm * 256 + 128 * ai + 64 * wr + 16 * m + fr) * DM + col0;
#pragma unroll
                for (int bj = 0; bj < 2; ++bj) { const f32x4 v0 = acc[ai][bj][m][0] * sv[bj][0], v1 = acc[ai][bj][m][1] * sv[bj][1];
                    u32x4 w; w.x = pk2(v0[0], v0[1]); w.y = pk2(v0[2], v0[3]); w.z = pk2(v1[0], v1[1]); w.w = pk2(v1[2], v1[3]); *(u32x4*)(rowp + bj * HALF) = w; } }
    }
};
struct EpiF32F {
    static constexpr bool PERM = false;
    float* C; int ldc;
    __device__ __forceinline__ void operator()(const f32x4 (&acc)[2][2][4][2], const Unit& u, int wr, int wc, int fr, int fq) const {
        const int col0 = u.pn * 256 + wc * 32 + 4 * fq;
#pragma unroll
        for (int ai = 0; ai < 2; ++ai)
#pragma unroll
            for (int m = 0; m < 4; ++m) { float* rowp = C + ((size_t)u.pm * 256 + 128 * ai + 64 * wr + 16 * m + fr) * ldc + col0;
#pragma unroll
                for (int bj = 0; bj < 2; ++bj)
#pragma unroll
                    for (int n = 0; n < 2; ++n) *(f32x4*)(rowp + bj * HALF + n * 16) = acc[ai][bj][m][n]; }
    }
};
struct EpiSwigluF {
    static constexpr bool PERM = true;
    bf16_t* ACT;
    __device__ __forceinline__ void operator()(const f32x4 (&acc)[2][2][4][2], const Unit& u, int wr, int wc, int fr, int fq) const {
        const int col0 = u.pn * 128 + wc * 32 + 8 * fq;
#pragma unroll
        for (int ai = 0; ai < 2; ++ai)
#pragma unroll
            for (int m = 0; m < 4; ++m) { bf16_t* rowp = ACT + ((size_t)u.pm * 256 + 128 * ai + 64 * wr + 16 * m + fr) * DFF + col0;
                float r[8];
#pragma unroll
                for (int n = 0; n < 2; ++n)
#pragma unroll
                    for (int e = 0; e < 4; ++e) { const float g = acc[ai][0][m][n][e], uu = acc[ai][1][m][n][e];
                        r[4 * n + e] = g * uu * __builtin_amdgcn_rcpf(1.0f + __builtin_amdgcn_exp2f(-1.4426950408889634f * g)); }
                u32x4 w; w.x = pk2(r[0], r[1]); w.y = pk2(r[2], r[3]); w.z = pk2(r[4], r[5]); w.w = pk2(r[6], r[7]); *(u32x4*)rowp = w; }
    }
};

template <class Epi, class Sched, bool ALIGN_EPI>
__device__ __forceinline__ void gemm_phase(LAS unsigned char* lds, const Gemm g, const Sched& S, const Epi& E) {
    const int tid = threadIdx.x, wid = __builtin_amdgcn_readfirstlane(tid >> 6), lane = tid & 63, wr = wid >> 2, wc = wid & 3, fr = lane & 15, fq = lane >> 4;
    const int K = g.K, nt = K / BK;
    unsigned voffA[2], voffB[2];
#pragma unroll
    for (int i = 0; i < 2; ++i) { int R, C; stage_rc(tid * 16 + i * 8192, R, C); const int Rb = Epi::PERM ? ((R & ~31) + perm32(R & 31)) : R;
        voffA[i] = (unsigned)(R * g.lda + C) * 2u; voffB[i] = (unsigned)(Rb * g.ldb + C) * 2u; }
    const size_t kstep = (size_t)(BK * 2);
    const size_t hstepA = (size_t)HALF * g.lda * 2, hstepB = (size_t)HALF * g.ldb * 2;
    const unsigned ldsw = (unsigned)wid * 1024u;
    const int aoff = lds_byte(wr * 64 + fr, fq * 8), boff = lds_byte(wc * 32 + fr, fq * 8);
#define PG8_SA(b, h) (((b) * 2 + (h)) * HTB)
#define PG8_SB(b, h) ((4 + (b) * 2 + (h)) * HTB)
#define PG8_STAGE(bufoff, gbase, voff) do { _Pragma("unroll") for (int _i = 0; _i < 2; ++_i) \
        __builtin_amdgcn_global_load_lds((const unsigned*)((const char*)(gbase) + (voff)[_i]), (LAS unsigned*)(lds + (bufoff) + ldsw + _i * 8192), 16, 0, 0); } while (0)
#define PG8_LDA(dst, b, h) do { _Pragma("unroll") for (int m = 0; m < 4; ++m) _Pragma("unroll") for (int k = 0; k < 2; ++k) dst[m][k] = *(const LAS bf16x8*)(lds + PG8_SA(b, h) + aoff + m * 2048 + k * 1024); } while (0)
#define PG8_LDB(dst, b, h) do { _Pragma("unroll") for (int n = 0; n < 2; ++n) _Pragma("unroll") for (int k = 0; k < 2; ++k) dst[n][k] = *(const LAS bf16x8*)(lds + PG8_SB(b, h) + boff + n * 2048 + k * 1024); } while (0)
#define PG8_MMA(ai, bj, At, Bt) do { __builtin_amdgcn_s_setprio(1); _Pragma("unroll") for (int m = 0; m < 4; ++m) _Pragma("unroll") for (int n = 0; n < 2; ++n) _Pragma("unroll") for (int k = 0; k < 2; ++k) \
        acc[ai][bj][m][n] = __builtin_amdgcn_mfma_f32_16x16x32_bf16(Bt[n][k], At[m][k], acc[ai][bj][m][n], 0, 0, 0); __builtin_amdgcn_s_setprio(0); } while (0)
#define PG8_WAIT_V(n) asm volatile("s_waitcnt vmcnt(" #n ")" ::: "memory")
#define PG8_WAIT_L(n) asm volatile("s_waitcnt lgkmcnt(" #n ")" ::: "memory")
#define PG8_BAR __builtin_amdgcn_s_barrier()
#define PG8_SCHED __builtin_amdgcn_sched_barrier(0)
    Unit cur, nxt; int ui = 0;
    if (!S.next(0, cur)) return;
    f32x4 acc[2][2][4][2];
#pragma unroll
    for (int a = 0; a < 2; ++a)
#pragma unroll
        for (int b = 0; b < 2; ++b)
#pragma unroll
            for (int m = 0; m < 4; ++m)
#pragma unroll
                for (int n = 0; n < 2; ++n) acc[a][b][m][n] = (f32x4){0.f, 0.f, 0.f, 0.f};
    bf16x8 At[4][2], B0[2][2], B1[2][2];
    const char* cA = (const char*)g.A + S.aoff(cur); const char* cB = (const char*)g.Bt + S.boff(cur);
    PG8_STAGE(PG8_SB(0, 0), cB, voffB); PG8_STAGE(PG8_SB(0, 1), cB + hstepB, voffB); PG8_STAGE(PG8_SA(0, 0), cA, voffA); PG8_STAGE(PG8_SA(0, 1), cA + hstepA, voffA);
    if (wr == 1) PG8_BAR;
    PG8_WAIT_V(2); PG8_BAR;
    PG8_STAGE(PG8_SB(1, 0), cB + kstep, voffB); PG8_STAGE(PG8_SA(1, 0), cA + kstep, voffA); PG8_STAGE(PG8_SB(1, 1), cB + hstepB + kstep, voffB);
    PG8_WAIT_V(6); PG8_BAR;
    for (;;) {
        const bool has_next = S.next(ui + 1, nxt);
        const char* nA = has_next ? (const char*)g.A + S.aoff(nxt) : cA; const char* nB = has_next ? (const char*)g.Bt + S.boff(nxt) : cB;
#pragma unroll 1
        for (int t = 0; t < nt; t += 2) {
            const bool last = (t == nt - 2);
            const char* a1 = cA + (size_t)(t + 1) * kstep;
            const char* a2 = last ? nA : cA + (size_t)(t + 2) * kstep; const char* b2 = last ? nB : cB + (size_t)(t + 2) * kstep;
            const char* a3 = a2 + kstep; const char* b3 = b2 + kstep;
            PG8_LDB(B0, 0, 0); PG8_LDB(B1, 0, 1); PG8_SCHED; PG8_LDA(At, 0, 0); PG8_STAGE(PG8_SA(1, 1), a1 + hstepA, voffA);
            PG8_WAIT_V(8); PG8_WAIT_L(0); PG8_BAR; PG8_MMA(0, 0, At, B0); PG8_MMA(0, 1, At, B1); PG8_BAR; PG8_SCHED;
            PG8_LDA(At, 0, 1); PG8_STAGE(PG8_SB(0, 0), b2, voffB); PG8_STAGE(PG8_SB(0, 1), b2 + hstepB, voffB); PG8_STAGE(PG8_SA(0, 0), a2, voffA);
            PG8_WAIT_V(8); PG8_WAIT_L(0); PG8_BAR; PG8_MMA(1, 0, At, B0); PG8_MMA(1, 1, At, B1); PG8_BAR; PG8_SCHED;
            PG8_LDB(B0, 1, 0); PG8_LDB(B1, 1, 1); PG8_SCHED; PG8_LDA(At, 1, 0); PG8_STAGE(PG8_SA(0, 1), a2 + hstepA, voffA);
            PG8_WAIT_V(8); PG8_WAIT_L(0); PG8_BAR; PG8_MMA(0, 0, At, B0); PG8_MMA(0, 1, At, B1); PG8_BAR; PG8_SCHED;
            PG8_LDA(At, 1, 1); PG8_STAGE(PG8_SB(1, 0), b3, voffB); PG8_STAGE(PG8_SB(1, 1), b3 + hstepB, voffB); PG8_STAGE(PG8_SA(1, 0), a3, voffA);
            PG8_WAIT_V(8); PG8_WAIT_L(0); PG8_BAR; PG8_MMA(1, 0, At, B0); PG8_MMA(1, 1, At, B1); PG8_BAR; PG8_SCHED;
        }
        if constexpr (ALIGN_EPI) { if (wr == 0) PG8_BAR; }
        E(acc, cur, wr, wc, fr, fq);
        if (!has_next) break;
#pragma unroll
        for (int a = 0; a < 2; ++a)
#pragma unroll
            for (int b = 0; b < 2; ++b)
#pragma unroll
                for (int m = 0; m < 4; ++m)
#pragma unroll
                    for (int n = 0; n < 2; ++n) acc[a][b][m][n] = (f32x4){0.f, 0.f, 0.f, 0.f};
        cur = nxt; cA = nA; cB = nB; ++ui;
        if constexpr (ALIGN_EPI) { if (wr == 1) PG8_BAR; }
    }
    PG8_WAIT_V(0);
    if constexpr (!ALIGN_EPI) { if (wr == 0) PG8_BAR; }
    PG8_BAR;
#undef PG8_SA
#undef PG8_SB
#undef PG8_STAGE
#undef PG8_LDA
#undef PG8_LDB
#undef PG8_MMA
#undef PG8_WAIT_V
#undef PG8_WAIT_L
#undef PG8_BAR
#undef PG8_SCHED
}
}

#define XB_TMO      128
#define XB_XCNT(j)  (256  + 64 * (j))
#define XB_XSUB(j)  (1280 + 64 * (j))
#define XB_XGEN(j)  (2304 + 64 * (j))
#define XB_TOP      3328
#define XB_TOPGEN   3392
#define XCD_BAR_WORDS 3456
#define XB_SPIN_CAP (1u << 18)
__device__ __forceinline__ unsigned xb_ld(unsigned* p)              { return __hip_atomic_load(p, __ATOMIC_RELAXED, __HIP_MEMORY_SCOPE_AGENT); }
__device__ __forceinline__ unsigned xb_add(unsigned* p, unsigned v) { return __hip_atomic_fetch_add(p, v, __ATOMIC_RELAXED, __HIP_MEMORY_SCOPE_AGENT); }
__device__ __forceinline__ unsigned xb_xcc_id() { return (unsigned)__builtin_amdgcn_s_getreg((3 << 11) | 20) & 0xFu; }
#define XB_SPIN(cond, bar) do { unsigned _sp = 0; while (cond) { __builtin_amdgcn_s_sleep(1); \
    if ((++_sp & 255u) == 0u) { if (xb_ld(&(bar)[XB_TMO])) break; if (_sp > XB_SPIN_CAP) { atomicAdd(&(bar)[XB_TMO], 1u); break; } } } } while (0)
struct XcdBarrier { unsigned* bar; unsigned x; volatile LAS unsigned* st; };
__device__ __forceinline__ XcdBarrier xcd_barrier_post(unsigned* bar, volatile LAS unsigned* st) {
    XcdBarrier b; b.bar = bar; b.x = xb_xcc_id(); b.st = st;
    if (threadIdx.x == 0) (void)xb_add(&bar[XB_XCNT(b.x)], 1u);
    return b;
}
__device__ __forceinline__ void xcd_barrier_complete(unsigned* bar, unsigned x, unsigned& nloc, unsigned& nx) {
    const unsigned G = gridDim.x * gridDim.y * gridDim.z;
    unsigned sum, cnt, mine, sp = 0u;
    for (;;) {
        sum = 0u; cnt = 0u; mine = 0u;
#pragma unroll
        for (unsigned j = 0; j < 16; ++j) { const unsigned c = xb_ld(&bar[XB_XCNT(j)]); sum += c; cnt += (c > 0u) ? 1u : 0u; mine = (j == x) ? c : mine; }
        if (sum == G) break;
        __builtin_amdgcn_s_sleep(1);
        if ((++sp & 255u) == 0u) { if (xb_ld(&bar[XB_TMO])) break; if (sp > XB_SPIN_CAP) { atomicAdd(&bar[XB_TMO], 1u); break; } }
    }
    nloc = mine > 0u ? mine : 1u; nx = cnt > 0u ? cnt : 1u;
}
__device__ __forceinline__ void xcd_barrier(const XcdBarrier& b) {
    asm volatile("s_waitcnt vmcnt(0)" ::: "memory");
    __syncthreads();
    if (threadIdx.x == 0) {
        unsigned* bar = b.bar;
        __builtin_amdgcn_s_waitcnt(0);
        unsigned nloc = b.st[0], nx = b.st[1];
        if (nloc == 0u) { xcd_barrier_complete(bar, b.x, nloc, nx); b.st[0] = nloc; b.st[1] = nx; }
        const unsigned old = xb_add(&bar[XB_XSUB(b.x)], 1u);
        const unsigned gen = old / nloc;
        if (old + 1u == (gen + 1u) * nloc) {
            __builtin_amdgcn_fence(__ATOMIC_RELEASE, "agent");
            asm volatile("s_waitcnt vmcnt(0)" ::: "memory");
            const unsigned og = xb_add(&bar[XB_TOP], 1u);
            const unsigned tg = og / nx;
            if (og + 1u == (tg + 1u) * nx) xb_add(&bar[XB_TOPGEN], 1u);
            else XB_SPIN(xb_ld(&bar[XB_TOPGEN]) == tg, bar);
            __builtin_amdgcn_fence(__ATOMIC_ACQUIRE, "agent");
            xb_add(&bar[XB_XGEN(b.x)], 1u);
            asm volatile("s_waitcnt vmcnt(0)" ::: "memory");
        } else {
            XB_SPIN(xb_ld(&bar[XB_XGEN(b.x)]) == gen, bar);
            __builtin_amdgcn_fence(__ATOMIC_ACQUIRE, "agent");
            asm volatile("s_waitcnt vmcnt(0)" ::: "memory");
        }
    }
    __syncthreads();
}

constexpr int RING_BYTES = 131072, LDSCTL_OFF = RING_BYTES, MISC_OFF = LDSCTL_OFF + 320, LDS_BYTES = 147456;
constexpr int CW_BAR = 4096;
constexpr int N_PHASES = 10;
#ifndef FAST_ATTN
#define FAST_ATTN 0
#endif
struct Args { Ptrs P; int ph_lo, ph_hi, li, pad; };
__global__ void __launch_bounds__(512, 2) mega_fwd(Args args) {
    extern __shared__ __attribute__((aligned(16))) unsigned char lds_raw[];
    LAS unsigned char* lds = (LAS unsigned char*)lds_raw;
    const Ptrs& P = args.P;
    const int tid = threadIdx.x, G = gridDim.x, bid = blockIdx.x;
    for (int u = tid; u < (LDS_BYTES - LDSCTL_OFF) / 4; u += 512) ((LAS unsigned*)(lds + LDSCTL_OFF))[u] = 0u;
    __syncthreads();
    volatile LAS unsigned* MISC = (volatile LAS unsigned*)(lds + MISC_OFF);
    unsigned* ctl = (unsigned*)(P.ws + WS_CTL);
    XcdBarrier bar = xcd_barrier_post(ctl + CW_BAR + args.li * XCD_BAR_WORDS, MISC + 8);
    const int lo = args.ph_lo, hi = args.ph_hi;
#ifdef PHASE_MASK
#define IN(k) (lo <= (k) && (k) < hi && ((PHASE_MASK >> (k)) & 1))
#else
#define IN(k) (lo <= (k) && (k) < hi)
#endif
#define SEAM(k) do { if (IN(k) && IN((k) + 1)) xcd_barrier(bar); } while (0)
    unsigned char* ws = P.ws;
    bf16_t* H = (bf16_t*)(ws + WS_H);
    if (IN(0)) { p0_prologue(P, bid, G, lds); SEAM(0); }
    if (IN(1)) { p1_rows(P, bid, G, lds); SEAM(1); }
    if (IN(2)) {
        pg8::Gemm g{H, (const bf16_t*)(ws + WS_WIN), DM, DM, DM}; pg8::SchedInproj S{G, bid};
        pg8::EpiInprojF E{(bf16_t*)(ws + WS_P), (bf16_t*)(ws + WS_Q), (bf16_t*)(ws + WS_K), (bf16_t*)(ws + WS_V), (const float*)(ws + WS_ROPE)};
        pg8::gemm_phase<pg8::EpiInprojF, pg8::SchedInproj, true>(lds, g, S, E);
        SEAM(2);
    }
    if (IN(3)) { p3_dp(P, bid, G); SEAM(3); }
    if (IN(4)) {
        pg8::Gemm g{(const bf16_t*)(ws + WS_DP), (const bf16_t*)(ws + WS_WPOOL), POOLW, 256, 256}; pg8::SchedPool S{G, bid};
        pg8::EpiPoolF E{(bf16_t*)(ws + WS_MIXIN), P.pool_scale};
        pg8::gemm_phase<pg8::EpiPoolF, pg8::SchedPool, true>(lds, g, S, E);
        SEAM(4);
    }
    if (IN(5)) {
        pg8::Gemm g{(const bf16_t*)(ws + WS_MIXIN), (const bf16_t*)(ws + WS_WOUT), DM, DM, DM}; pg8::SchedStd S{32, 8, G, bid, DM, DM};
        pg8::EpiF32F E{(float*)(ws + WS_MIX), DM};
        pg8::gemm_phase<pg8::EpiF32F, pg8::SchedStd, true>(lds, g, S, E);
        SEAM(5);
    }
    if (IN(6)) { p6_rows(P, bid, G, lds); SEAM(6); }
    if (IN(7)) {
        pg8::Gemm g{H, (const bf16_t*)(ws + WS_WGU), DM, DM, DM}; pg8::SchedStd S{32, 44, G, bid, DM, DM};
        pg8::EpiSwigluF E{(bf16_t*)(ws + WS_ACT)};
        pg8::gemm_phase<pg8::EpiSwigluF, pg8::SchedStd, true>(lds, g, S, E);
        SEAM(7);
    }
    if (IN(8)) {
        pg8::Gemm g{(const bf16_t*)(ws + WS_ACT), (const bf16_t*)(ws + WS_WDN), DFF, DFF, DFF}; pg8::SchedStd S{32, 8, G, bid, DFF, DFF};
        pg8::EpiF32F E{(float*)(ws + WS_MIX), DM};
        pg8::gemm_phase<pg8::EpiF32F, pg8::SchedStd, true>(lds, g, S, E);
        SEAM(8);
    }
    if (IN(9)) { p9_rows(P, bid, G, lds); }
#undef IN
#undef SEAM
}

extern "C" void kernel_launch(void* const* d_in, const int* in_sizes, int n_in, void* d_out, int out_size, void* d_ws, size_t ws_size, hipStream_t stream) {
    static int ok = 0;
    if (ok == 0) {
        if (n_in != 21 || in_sizes[0] != MLAT * DM || out_size != MLAT * DM || ws_size < WS_END) {
            fprintf(stderr, "kernel_launch: unexpected shapes: n_in %d in0 %d out %d ws %zu (need >= %zu)\n", n_in, n_in > 0 ? in_sizes[0] : -1, out_size, ws_size, (size_t)WS_END); ok = -1; return; }
        if (hipFuncSetAttribute((const void*)mega_fwd, hipFuncAttributeMaxDynamicSharedMemorySize, LDS_BYTES) != hipSuccess) { fprintf(stderr, "kernel_launch: hipFuncSetAttribute failed\n"); ok = -1; return; }
        int dev = 0, cus = 0, per_cu = 0;
        if (hipGetDevice(&dev) != hipSuccess || hipDeviceGetAttribute(&cus, hipDeviceAttributeMultiprocessorCount, dev) != hipSuccess) { ok = -1; return; }
        if (hipOccupancyMaxActiveBlocksPerMultiprocessor(&per_cu, (const void*)mega_fwd, 512, LDS_BYTES) != hipSuccess || per_cu < 1) fprintf(stderr, "kernel_launch: occupancy query reports %d blocks per CU\n", per_cu);
        (void)hipGetLastError();
        if (cus != 256) fprintf(stderr, "kernel_launch: %d CUs (built for 256)\n", cus);
        ok = cus;
    }
    if (ok < 0) return;
    const int grid = ok;
    Ptrs P{};
#define IN_(i) ((const float*)d_in[i])
    P.x = IN_(0); P.c = IN_(1); P.ctx = IN_(2); P.c_ctx = IN_(3); P.w_ada = IN_(4); P.b_ada = IN_(5); P.g_pre_mix = IN_(6); P.g_post_mix = IN_(7);
    P.g_pre_ffn = IN_(8); P.g_post_ffn = IN_(9); P.w_in = IN_(10); P.w_pool = IN_(11); P.pool_scale = IN_(12); P.lq1 = IN_(13); P.lk1 = IN_(14);
    P.lq2 = IN_(15); P.lk2 = IN_(16); P.g_subln = IN_(17); P.w_out = IN_(18); P.w_gu = IN_(19); P.w_dn = IN_(20);
#undef IN_
    P.out = (float*)d_out; P.ws = (unsigned char*)d_ws;
    if (hipMemsetAsync((char*)d_ws + WS_CTL, 0, CTL_ZERO_BYTES, stream) != hipSuccess) { fprintf(stderr, "kernel_launch: hipMemsetAsync failed\n"); return; }
    Args a{}; a.P = P;
#if FAST_ATTN
    a.ph_lo = 0; a.ph_hi = N_PHASES; a.li = 0;
    hipLaunchKernelGGL(mega_fwd, dim3(grid), dim3(512), LDS_BYTES, stream, a);
#else
    a.ph_lo = 0; a.ph_hi = 4; a.li = 0;
    hipLaunchKernelGGL(mega_fwd, dim3(grid), dim3(512), LDS_BYTES, stream, a);
    hipLaunchKernelGGL(k_sattn, dim3(MLAT / 4, NH), dim3(256), 0, stream, P);
    a.ph_lo = 4; a.ph_hi = N_PHASES; a.li = 1;
    hipLaunchKernelGGL(mega_fwd, dim3(grid), dim3(512), LDS_BYTES, stream, a);
#endif
    const hipError_t le = hipPeekAtLastError();
    if (le != hipSuccess) fprintf(stderr, "kernel_launch: launch failed: %s\n", hipGetErrorName(le));
}
```

```cpp
#include <hip/hip_runtime.h>
#include <cstdio>
#include <cstdint>

#define GAS __attribute__((address_space(1)))
#define LAS __attribute__((address_space(3)))
typedef unsigned short bf16_t;
typedef short bf16x8 __attribute__((ext_vector_type(8)));
typedef float f32x4 __attribute__((ext_vector_type(4)));
typedef float f32x2 __attribute__((ext_vector_type(2)));
typedef unsigned u32x4 __attribute__((ext_vector_type(4)));
typedef unsigned u32x2 __attribute__((ext_vector_type(2)));

constexpr int DM = 2048, NB = 4, SEQ = 2048, CTXL = 256, MLAT = NB * SEQ, MCTX = NB * CTXL, MALL = MLAT + MCTX;
constexpr int NIN = 4096, POOLW = 1024, ATTW = 1024, NH = 8, VHD = 128, QKD = 64, DFF = 5632, NMOD = 6 * DM, KVL = CTXL + SEQ;
constexpr int NBM = NB + 1;
constexpr int KSLAB = 8;
constexpr float EPS = 1e-6f;
constexpr float QSCALE = 0.125f * 1.4426950408889634f;
constexpr float LAMBDA_INIT = 0.2f;

constexpr size_t MiB = 1u << 20;
constexpr size_t WS_CTL = 0, CTL_ZERO_BYTES = 1 * MiB;
constexpr size_t WS_MODP = 1 * MiB;
constexpr size_t WS_MOD = 3 * MiB;
constexpr size_t WS_ROPE = 3 * MiB + 512 * 1024;
constexpr size_t WS_WPOOL = 4 * MiB;
constexpr size_t WS_WIN = 8 * MiB;
constexpr size_t WS_WOUT = 24 * MiB;
constexpr size_t WS_WGU = 32 * MiB;
constexpr size_t WS_WDN = 76 * MiB;
constexpr size_t WS_H = 98 * MiB;
constexpr size_t WS_P = 134 * MiB;
constexpr size_t WS_Q = 150 * MiB;
constexpr size_t WS_K = 166 * MiB;
constexpr size_t WS_V = 184 * MiB;
constexpr size_t WS_DP = 202 * MiB;
constexpr size_t WS_MIXIN = 218 * MiB;
constexpr size_t WS_ACT = 134 * MiB;
constexpr size_t WS_MIX = 250 * MiB;
constexpr size_t WS_END = 314 * MiB;

struct Ptrs {
    const float *x, *c, *ctx, *c_ctx, *w_ada, *b_ada, *g_pre_mix, *g_post_mix, *g_pre_ffn, *g_post_ffn, *w_in, *w_pool, *pool_scale;
    const float *lq1, *lk1, *lq2, *lk2, *g_subln, *w_out, *w_gu, *w_dn;
    float* out; unsigned char* ws;
};

__device__ __forceinline__ unsigned f2bf(float f) { unsigned u = __builtin_bit_cast(unsigned, f); return (u + 0x7fffu + ((u >> 16) & 1u)) >> 16; }
__device__ __forceinline__ unsigned pk2(float lo, float hi) { return f2bf(lo) | (f2bf(hi) << 16); }
__device__ __forceinline__ float bf2f(unsigned short b) { return __builtin_bit_cast(float, (unsigned)b << 16); }
__device__ __forceinline__ float wave_sum(float v) {
#pragma unroll
    for (int o = 1; o < 64; o <<= 1) v += __shfl_xor(v, o);
    return v;
}
__device__ __forceinline__ float wave_max(float v) {
#pragma unroll
    for (int o = 1; o < 64; o <<= 1) v = fmaxf(v, __shfl_xor(v, o));
    return v;
}

__device__ __forceinline__ void p0_gemv_item(const Ptrs& P, int it, LAS unsigned char* lds, int tid) {
    const int ks = it / 32, ns = it % 32;
    LAS float* s_silu = (LAS float*)lds;
    LAS f32x4* red = (LAS f32x4*)(lds + 8192);
    if (tid < 256) {
#pragma unroll
        for (int b = 0; b < NBM; ++b) {
            const float v = (b < NB) ? P.c[b * DM + ks * 256 + tid] : P.c_ctx[ks * 256 + tid];
            s_silu[b * 256 + tid] = v / (1.0f + expf(-v));
        }
    }
    __syncthreads();
    if (tid < 384) {
        const int col4 = tid % 96, ksub = tid / 96;
        f32x4 acc[NBM];
#pragma unroll
        for (int b = 0; b < NBM; ++b) acc[b] = (f32x4){0.f, 0.f, 0.f, 0.f};
        const float* wp = P.w_ada + (size_t)(ks * 256 + ksub * 64) * NMOD + ns * 384 + col4 * 4;
#pragma unroll 8
        for (int kk = 0; kk < 64; ++kk) {
            const f32x4 w = *(const f32x4*)(wp + (size_t)kk * NMOD);
#pragma unroll
            for (int b = 0; b < NBM; ++b) acc[b] += w * s_silu[b * 256 + ksub * 64 + kk];
        }
#pragma unroll
        for (int b = 0; b < NBM; ++b) red[(ksub * NBM + b) * 96 + col4] = acc[b];
    }
    __syncthreads();
    if (tid < NBM * 96) {
        const int b = tid / 96, c4 = tid % 96;
        f32x4 s = red[(0 * NBM + b) * 96 + c4];
        s += red[(1 * NBM + b) * 96 + c4]; s += red[(2 * NBM + b) * 96 + c4]; s += red[(3 * NBM + b) * 96 + c4];
        float* modp = (float*)(P.ws + WS_MODP);
        *(f32x4*)(modp + ((size_t)ks * NBM + b) * NMOD + ns * 384 + c4 * 4) = s;
    }
    __syncthreads();
}
__device__ __forceinline__ void p0_transpose_item(const float* W, int K, int N, bf16_t* WT, int k0, int n0, int drow0, LAS float* scr, int lane) {
#pragma unroll 8
    for (int i = 0; i < 32; ++i) { const int kk = 2 * i + (lane >> 5); scr[kk * 33 + (lane & 31)] = W[(size_t)(k0 + kk) * N + n0 + (lane & 31)]; }
    asm volatile("s_waitcnt lgkmcnt(0)" ::: "memory");
    const int c = lane & 7;
#pragma unroll
    for (int j = 0; j < 4; ++j) { const int n = (lane >> 3) + 8 * j; const LAS float* s = scr + (8 * c) * 33 + n;
        u32x4 o; o.x = pk2(s[0 * 33], s[1 * 33]); o.y = pk2(s[2 * 33], s[3 * 33]); o.z = pk2(s[4 * 33], s[5 * 33]); o.w = pk2(s[6 * 33], s[7 * 33]);
        *(u32x4*)(WT + (size_t)(drow0 + n) * K + k0 + 8 * c) = o; }
    asm volatile("s_waitcnt lgkmcnt(0)" ::: "memory");
}
__device__ __forceinline__ void p0_prologue(const Ptrs& P, int bid, int G, LAS unsigned char* lds) {
    const int tid = threadIdx.x, lane = tid & 63, wave = tid >> 6;
    for (int it = bid; it < KSLAB * 32; it += G) p0_gemv_item(P, it, lds, tid);
    if (bid == 0) {
        float* rope = (float*)(P.ws + WS_ROPE);
        for (int idx = tid; idx < 64 * 16; idx += 512) {
            const int pos = idx / 16, i = idx % 16;
            const float inv = powf(10000.0f, -(float)i / 16.0f);
            const float ang = (float)pos * inv;
            rope[idx] = cosf(ang); rope[1024 + idx] = sinf(ang);
        }
        if (wave == 0) {
            const float s1 = wave_sum(P.lq1[lane] * P.lk1[lane]), s2 = wave_sum(P.lq2[lane] * P.lk2[lane]);
            if (lane == 0) rope[2048] = expf(s1) - expf(s2) + LAMBDA_INIT;
        }
    }
    __syncthreads();
    LAS float* scr = (LAS float*)(lds + wave * 16384);
    const int gw = bid * 8 + wave, NGW = G * 8;
    constexpr int I_IN = (DM / 64) * (NIN / 32), I_OUT = (DM / 64) * (DM / 32), I_GU = (DM / 64) * (2 * DFF / 32), I_DN = (DFF / 64) * (DM / 32), I_PL = 4 * (256 / 64) * (256 / 32);
    constexpr int NITEMS = I_IN + I_OUT + I_GU + I_DN + I_PL;
    for (int it = gw; it < NITEMS; it += NGW) {
        int r = it;
        if (r < I_IN) { const int nblk = NIN / 32, kb = r / nblk, nb = r % nblk; p0_transpose_item(P.w_in, DM, NIN, (bf16_t*)(P.ws + WS_WIN), 64 * kb, 32 * nb, 32 * nb, scr, lane); continue; } r -= I_IN;
        if (r < I_OUT) { const int nblk = DM / 32, kb = r / nblk, nb = r % nblk; p0_transpose_item(P.w_out, DM, DM, (bf16_t*)(P.ws + WS_WOUT), 64 * kb, 32 * nb, 32 * nb, scr, lane); continue; } r -= I_OUT;
        if (r < I_GU) { const int nblk = 2 * DFF / 32, kb = r / nblk, nb = r % nblk; const int n0 = 32 * nb, bj = n0 / DFF, rem = n0 % DFF, pn = rem / 128, cl = rem % 128;
            p0_transpose_item(P.w_gu, DM, 2 * DFF, (bf16_t*)(P.ws + WS_WGU), 64 * kb, n0, 256 * pn + 128 * bj + cl, scr, lane); continue; } r -= I_GU;
        if (r < I_DN) { const int nblk = DM / 32, kb = r / nblk, nb = r % nblk; p0_transpose_item(P.w_dn, DFF, DM, (bf16_t*)(P.ws + WS_WDN), 64 * kb, 32 * nb, 32 * nb, scr, lane); continue; } r -= I_DN;
        { const int g = r / 32, rr = r % 32, kb = rr / 8, nb = rr % 8; p0_transpose_item(P.w_pool + (size_t)g * 65536, 256, 256, (bf16_t*)(P.ws + WS_WPOOL) + (size_t)g * 65536, 64 * kb, 32 * nb, 32 * nb, scr, lane); }
    }
}

__device__ __forceinline__ void row_modnorm(const float* xrow, bf16_t* orow, const LAS float* a, const LAS float* s, int lane) {
    f32x4 v[8]; float ss = 0.f;
#pragma unroll
    for (int j = 0; j < 8; ++j) { v[j] = *((const f32x4*)xrow + lane + 64 * j); ss += (v[j].x * v[j].x + v[j].y * v[j].y) + (v[j].z * v[j].z + v[j].w * v[j].w); }
    const float inv = 1.0f / sqrtf(wave_sum(ss) * (1.0f / DM) + EPS);
#pragma unroll
    for (int j = 0; j < 8; ++j) { const f32x4 av = *((const LAS f32x4*)a + lane + 64 * j), sv = *((const LAS f32x4*)s + lane + 64 * j);
        const f32x4 y = v[j] * inv * av + sv; u32x2 o; o.x = pk2(y.x, y.y); o.y = pk2(y.z, y.w); *((u32x2*)orow + lane + 64 * j) = o; }
}
__device__ __forceinline__ void p1_rows(const Ptrs& P, int bid, int G, LAS unsigned char* lds) {
    const int tid = threadIdx.x, lane = tid & 63, wave = tid >> 6;
    const float* modp = (const float*)(P.ws + WS_MODP); float* mod = (float*)(P.ws + WS_MOD);
    for (int e = bid * 512 + tid; e < NBM * NMOD; e += G * 512) { float s = P.b_ada[e % NMOD];
#pragma unroll
        for (int k = 0; k < KSLAB; ++k) s += modp[(size_t)k * NBM * NMOD + e];
        mod[e] = s; }
    LAS float* la = (LAS float*)lds; LAS float* ls = (LAS float*)(lds + 8192);
    bf16_t* H = (bf16_t*)(P.ws + WS_H);
    for (int rb = bid; rb < 256 + 256; rb += G) {
        const bool isctx = rb >= 256; const int b = isctx ? NB : rb / 64;
        __syncthreads();
        for (int k = tid; k < DM; k += 512) { float sh = P.b_ada[k], sc = P.b_ada[DM + k];
#pragma unroll
            for (int s = 0; s < KSLAB; ++s) { sh += modp[((size_t)s * NBM + b) * NMOD + k]; sc += modp[((size_t)s * NBM + b) * NMOD + DM + k]; }
            la[k] = P.g_pre_mix[k] * (1.0f + sc); ls[k] = sh; }
        __syncthreads();
        if (!isctx) { for (int i = 0; i < 4; ++i) { const int row = rb * 32 + wave * 4 + i; row_modnorm(P.x + (size_t)row * DM, H + (size_t)row * DM, la, ls, lane); } }
        else if (wave < 4) { const int row = (rb - 256) * 4 + wave; row_modnorm(P.ctx + (size_t)row * DM, H + (size_t)(MLAT + row) * DM, la, ls, lane); }
    }
}
__device__ __forceinline__ void p6_rows(const Ptrs& P, int bid, int G, LAS unsigned char* lds) {
    const int tid = threadIdx.x, lane = tid & 63, wave = tid >> 6;
    const float* mod = (const float*)(P.ws + WS_MOD); const float* MIX = (const float*)(P.ws + WS_MIX);
    LAS float* lg = (LAS float*)lds; LAS float* la = (LAS float*)(lds + 8192); LAS float* ls = (LAS float*)(lds + 16384);
    bf16_t* H = (bf16_t*)(P.ws + WS_H);
    for (int rb = bid; rb < 256; rb += G) {
        const int b = rb / 64;
        __syncthreads();
        for (int k = tid; k < DM; k += 512) { lg[k] = mod[b * NMOD + 2 * DM + k] * P.g_post_mix[k]; la[k] = P.g_pre_ffn[k] * (1.0f + mod[b * NMOD + 4 * DM + k]); ls[k] = mod[b * NMOD + 3 * DM + k]; }
        __syncthreads();
        for (int i = 0; i < 4; ++i) {
            const int row = rb * 32 + wave * 4 + i;
            const float* mrow = MIX + (size_t)row * DM; const float* xrow = P.x + (size_t)row * DM; float* orow = P.out + (size_t)row * DM;
            f32x4 v[8]; float ss = 0.f;
#pragma unroll
            for (int j = 0; j < 8; ++j) { v[j] = *((const f32x4*)mrow + lane + 64 * j); ss += (v[j].x * v[j].x + v[j].y * v[j].y) + (v[j].z * v[j].z + v[j].w * v[j].w); }
            const float inv = 1.0f / sqrtf(wave_sum(ss) * (1.0f / DM) + EPS); float s2 = 0.f;
#pragma unroll
            for (int j = 0; j < 8; ++j) { const f32x4 xv = *((const f32x4*)xrow + lane + 64 * j), gv = *((const LAS f32x4*)lg + lane + 64 * j);
                v[j] = xv + v[j] * inv * gv; *((f32x4*)orow + lane + 64 * j) = v[j]; s2 += (v[j].x * v[j].x + v[j].y * v[j].y) + (v[j].z * v[j].z + v[j].w * v[j].w); }
            const float inv2 = 1.0f / sqrtf(wave_sum(s2) * (1.0f / DM) + EPS);
#pragma unroll
            for (int j = 0; j < 8; ++j) { const f32x4 av = *((const LAS f32x4*)la + lane + 64 * j), sv = *((const LAS f32x4*)ls + lane + 64 * j);
                const f32x4 y = v[j] * inv2 * av + sv; u32x2 o; o.x = pk2(y.x, y.y); o.y = pk2(y.z, y.w); *((u32x2*)(H + (size_t)row * DM) + lane + 64 * j) = o; }
        }
    }
}
__device__ __forceinline__ void p9_rows(const Ptrs& P, int bid, int G, LAS unsigned char* lds) {
    const int tid = threadIdx.x, lane = tid & 63, wave = tid >> 6;
    const float* mod = (const float*)(P.ws + WS_MOD); const float* FFN = (const float*)(P.ws + WS_MIX);
    LAS float* lg = (LAS float*)lds;
    for (int rb = bid; rb < 256; rb += G) {
        const int b = rb / 64;
        __syncthreads();
        for (int k = tid; k < DM; k += 512) lg[k] = mod[b * NMOD + 5 * DM + k] * P.g_post_ffn[k];
        __syncthreads();
        for (int i = 0; i < 4; ++i) {
            const int row = rb * 32 + wave * 4 + i;
            const float* frow = FFN + (size_t)row * DM; float* orow = P.out + (size_t)row * DM;
            f32x4 v[8]; float ss = 0.f;
#pragma unroll
            for (int j = 0; j < 8; ++j) { v[j] = *((const f32x4*)frow + lane + 64 * j); ss += (v[j].x * v[j].x + v[j].y * v[j].y) + (v[j].z * v[j].z + v[j].w * v[j].w); }
            const float inv = 1.0f / sqrtf(wave_sum(ss) * (1.0f / DM) + EPS);
#pragma unroll
            for (int j = 0; j < 8; ++j) { const f32x4 xv = *((const f32x4*)orow + lane + 64 * j), gv = *((const LAS f32x4*)lg + lane + 64 * j);
                *((f32x4*)orow + lane + 64 * j) = xv + v[j] * inv * gv; }
        }
    }
}
__device__ __forceinline__ void p3_dp(const Ptrs& P, int bid, int G) {
    const int tid = threadIdx.x; const bf16_t* Pp = (const bf16_t*)(P.ws + WS_P); bf16_t* Dp = (bf16_t*)(P.ws + WS_DP);
    for (int rb = bid; rb < 256; rb += G) {
        const int cg = tid & 127, run = tid >> 7, grp = cg >> 5, hw = 1 << grp;
        const int t0 = rb * 32 + run * 8, b = t0 / SEQ, tl0 = t0 % SEQ;
        const bf16_t* base = Pp + (size_t)b * SEQ * POOLW + cg * 8;
        float sum[8];
#pragma unroll
        for (int e = 0; e < 8; ++e) sum[e] = 0.f;
        { const int lo = max(tl0 - hw, 0), hi = min(tl0 + hw, SEQ);
          for (int r = lo; r < hi; ++r) { const bf16x8 v = *(const bf16x8*)(base + (size_t)r * POOLW);
#pragma unroll
              for (int e = 0; e < 8; ++e) sum[e] += bf2f((unsigned short)v[e]); } }
        for (int i = 0; i < 8; ++i) {
            const int tl = tl0 + i; const int lo = max(tl - hw, 0), hi = min(tl + hw, SEQ); const float rc = 1.0f / (float)(hi - lo);
            const bf16x8 pv = *(const bf16x8*)(base + (size_t)tl * POOLW);
            u32x4 o; float d[8];
#pragma unroll
            for (int e = 0; e < 8; ++e) d[e] = sum[e] * rc - bf2f((unsigned short)pv[e]);
            o.x = pk2(d[0], d[1]); o.y = pk2(d[2], d[3]); o.z = pk2(d[4], d[5]); o.w = pk2(d[6], d[7]);
            *(u32x4*)(Dp + (size_t)(t0 + i) * POOLW + cg * 8) = o;
            if (i < 7) {
                if (tl + hw < SEQ) { const bf16x8 v = *(const bf16x8*)(base + (size_t)(tl + hw) * POOLW);
#pragma unroll
                    for (int e = 0; e < 8; ++e) sum[e] += bf2f((unsigned short)v[e]); }
                if (tl - hw >= 0) { const bf16x8 v = *(const bf16x8*)(base + (size_t)(tl - hw) * POOLW);
#pragma unroll
                    for (int e = 0; e < 8; ++e) sum[e] -= bf2f((unsigned short)v[e]); }
            }
        }
    }
}

__global__ void __launch_bounds__(512) k_p0(Ptrs P) { extern __shared__ __attribute__((aligned(16))) unsigned char lds[]; p0_prologue(P, blockIdx.x, gridDim.x, (LAS unsigned char*)lds); }
__global__ void __launch_bounds__(512) k_p1(Ptrs P) { extern __shared__ __attribute__((aligned(16))) unsigned char lds[]; p1_rows(P, blockIdx.x, gridDim.x, (LAS unsigned char*)lds); }
__global__ void __launch_bounds__(512) k_dp(Ptrs P) { p3_dp(P, blockIdx.x, gridDim.x); }
__global__ void __launch_bounds__(512) k_p6(Ptrs P) { extern __shared__ __attribute__((aligned(16))) unsigned char lds[]; p6_rows(P, blockIdx.x, gridDim.x, (LAS unsigned char*)lds); }
__global__ void __launch_bounds__(512) k_p9(Ptrs P) { extern __shared__ __attribute__((aligned(16))) unsigned char lds[]; p9_rows(P, blockIdx.x, gridDim.x, (LAS unsigned char*)lds); }

struct EpiInproj {
    bf16_t *Pb, *Q, *K, *V; const float* rope;
    __device__ __forceinline__ void operator()(int row, int col, float v0, float v1) const {
        const int region = col >> 10, cc = col & 1023;
        if (row < MLAT) {
            const int b = row / SEQ, t = row % SEQ; const size_t krow = (size_t)b * KVL + CTXL + t;
            if (region == 0) { Pb[(size_t)row * POOLW + cc] = (bf16_t)f2bf(v0); Pb[(size_t)row * POOLW + cc + 16] = (bf16_t)f2bf(v1); }
            else if (region == 3) { V[krow * ATTW + cc] = (bf16_t)f2bf(v0); V[krow * ATTW + cc + 16] = (bf16_t)f2bf(v1); }
            else {
                const int within = cc & 63, half = within >> 5, i = within & 31;
                const int pos = half ? (t & 63) : (t >> 6);
                const float cs = rope[pos * 16 + i], sn = rope[1024 + pos * 16 + i];
                float o0 = v0 * cs - v1 * sn, o1 = v0 * sn + v1 * cs;
                if (region == 1) { o0 *= QSCALE; o1 *= QSCALE; Q[(size_t)row * ATTW + cc] = (bf16_t)f2bf(o0); Q[(size_t)row * ATTW + cc + 16] = (bf16_t)f2bf(o1); }
                else { K[krow * ATTW + cc] = (bf16_t)f2bf(o0); K[krow * ATTW + cc + 16] = (bf16_t)f2bf(o1); }
            }
        } else {
            const int r = row - MLAT, b = r / CTXL, j = r % CTXL; const size_t krow = (size_t)b * KVL + j;
            if (region == 2) { K[krow * ATTW + cc] = (bf16_t)f2bf(v0); K[krow * ATTW + cc + 16] = (bf16_t)f2bf(v1); }
            else if (region == 3) { V[krow * ATTW + cc] = (bf16_t)f2bf(v0); V[krow * ATTW + cc + 16] = (bf16_t)f2bf(v1); }
        }
    }
};
struct EpiPool {
    bf16_t* MIXIN; const float* pool_scale;
    __device__ __forceinline__ void operator()(int row, int col, float v0, float v1) const {
        MIXIN[(size_t)row * DM + col] = (bf16_t)f2bf(v0 * pool_scale[col]); MIXIN[(size_t)row * DM + col + 16] = (bf16_t)f2bf(v1 * pool_scale[col + 16]); }
};
struct EpiF32 {
    float* C; int ldc;
    __device__ __forceinline__ void operator()(int row, int col, float v0, float v1) const { C[(size_t)row * ldc + col] = v0; C[(size_t)row * ldc + col + 16] = v1; }
};
struct EpiSwiglu {
    bf16_t* ACT;
    __device__ __forceinline__ void operator()(int row, int col, float g, float u) const {
        ACT[(size_t)row * DFF + col] = (bf16_t)f2bf(g / (1.0f + expf(-g)) * u); }
};
template <class Epi, bool DUAL>
__global__ void __launch_bounds__(256) k_sgemm(const bf16_t* A, int lda, const bf16_t* Bt, int ldb, int K, Epi E, int erow_off, int ecol_off) {
    const int tid = threadIdx.x, wave = tid >> 6, lane = tid & 63, fr = lane & 15, fq = lane >> 4;
    const int row0 = blockIdx.y * 64 + wave * 16, col0 = blockIdx.x * 64;
    f32x4 acc[4], acc2[4];
#pragma unroll
    for (int n = 0; n < 4; ++n) { acc[n] = (f32x4){0.f, 0.f, 0.f, 0.f}; acc2[n] = (f32x4){0.f, 0.f, 0.f, 0.f}; }
    const bf16_t* ap = A + (size_t)(row0 + fr) * lda + 8 * fq;
    const int brow0 = DUAL ? (256 * (col0 / 128) + (col0 % 128)) : col0;
    const bf16_t* bp = Bt + (size_t)(brow0 + fr) * ldb + 8 * fq;
    for (int k0 = 0; k0 < K; k0 += 32) {
        const bf16x8 a = *(const bf16x8*)(ap + k0);
#pragma unroll
        for (int n = 0; n < 4; ++n) {
            const bf16x8 b = *(const bf16x8*)(bp + (size_t)(16 * n) * ldb + k0);
            acc[n] = __builtin_amdgcn_mfma_f32_16x16x32_bf16(a, b, acc[n], 0, 0, 0);
            if (DUAL) { const bf16x8 b2 = *(const bf16x8*)(bp + (size_t)(128 + 16 * n) * ldb + k0); acc2[n] = __builtin_amdgcn_mfma_f32_16x16x32_bf16(a, b2, acc2[n], 0, 0, 0); }
        }
    }
#pragma unroll
    for (int i = 0; i < 4; ++i) {
        const int row = erow_off + row0 + 4 * fq + i;
        if (DUAL) {
#pragma unroll
            for (int n = 0; n < 4; ++n) E(row, ecol_off + col0 + 16 * n + fr, acc[n][i], acc2[n][i]);
        } else {
            E(row, ecol_off + col0 + fr, acc[0][i], acc[1][i]);
            E(row, ecol_off + col0 + 32 + fr, acc[2][i], acc[3][i]);
        }
    }
}
__global__ void __launch_bounds__(256) k_sattn(Ptrs P) {
    __shared__ float sc[4][KVL];
    const int tid = threadIdx.x, wave = tid >> 6, lane = tid & 63;
    const int row = blockIdx.x * 4 + wave, h = blockIdx.y, b = row / SEQ;
    const bf16_t* Q = (const bf16_t*)(P.ws + WS_Q); const bf16_t* Kb = (const bf16_t*)(P.ws + WS_K) + (size_t)b * KVL * ATTW + h * VHD;
    const bf16_t* Vb = (const bf16_t*)(P.ws + WS_V) + (size_t)b * KVL * ATTW + h * VHD;
    const float lam = ((const float*)(P.ws + WS_ROPE))[2048];
    float o[2][2];
    for (int map = 0; map < 2; ++map) {
        float q[64];
#pragma unroll
        for (int d8 = 0; d8 < 8; ++d8) { const bf16x8 v = *(const bf16x8*)(Q + (size_t)row * ATTW + h * VHD + map * 64 + d8 * 8);
#pragma unroll
            for (int e = 0; e < 8; ++e) q[d8 * 8 + e] = bf2f((unsigned short)v[e]); }
        float mx = -1e30f;
        for (int i = 0; i < KVL / 64; ++i) { const int key = lane + 64 * i; const bf16_t* kp = Kb + (size_t)key * ATTW + map * 64; float s = 0.f;
#pragma unroll
            for (int d8 = 0; d8 < 8; ++d8) { const bf16x8 v = *(const bf16x8*)(kp + d8 * 8);
#pragma unroll
                for (int e = 0; e < 8; ++e) s += q[d8 * 8 + e] * bf2f((unsigned short)v[e]); }
            sc[wave][key] = s; mx = fmaxf(mx, s); }
        mx = wave_max(mx); float l = 0.f;
        for (int i = 0; i < KVL / 64; ++i) { const int key = lane + 64 * i; const float p = exp2f(sc[wave][key] - mx); sc[wave][key] = p; l += p; }
        l = wave_sum(l);
        __syncthreads();
        float a0 = 0.f, a1 = 0.f;
        for (int key = 0; key < KVL; ++key) { const float p = sc[wave][key]; const unsigned vv = *(const unsigned*)(Vb + (size_t)key * ATTW + 2 * lane);
            a0 += p * bf2f((unsigned short)(vv & 0xffffu)); a1 += p * bf2f((unsigned short)(vv >> 16)); }
        o[map][0] = a0 / l; o[map][1] = a1 / l;
    }
    const float d0 = o[0][0] - lam * o[1][0], d1 = o[0][1] - lam * o[1][1];
    const float ss = wave_sum(d0 * d0 + d1 * d1);
    const float inv = 1.0f / sqrtf(ss * (1.0f / VHD) + EPS) * (1.0f - LAMBDA_INIT);
    bf16_t* MIXIN = (bf16_t*)(P.ws + WS_MIXIN);
    *(unsigned*)(MIXIN + (size_t)row * DM + POOLW + h * VHD + 2 * lane) = pk2(d0 * inv * P.g_subln[2 * lane], d1 * inv * P.g_subln[2 * lane + 1]);
}

namespace pg8 {
constexpr int BM = 256, BK = 64, HALF = 128, HTB = HALF * BK * 2  , STAGE_BYTES = 8 * HTB, NXCD = 8, WGM = 8;
__host__ __device__ __forceinline__ int lds_byte(int r, int c) { const int st = (r >> 4) * 2 + (c >> 5), rr = r & 15, cc = c & 31, ob = rr * 64 + cc * 2; return st * 1024 + (ob ^ (((ob >> 9) & 1) << 5)); }
__host__ __device__ __forceinline__ void stage_rc(int b, int& R, int& C) { const int st = b / 1024, sb = b % 1024, swz = sb ^ (((sb >> 9) & 1) << 5); R = (st >> 1) * 16 + swz / 64; C = (st & 1) * 32 + (swz % 64) / 2; }
__host__ __device__ __forceinline__ int perm32(int rho) { const int n = rho >> 4, i = rho & 15; return 8 * (i >> 2) + 4 * n + (i & 3); }

struct Unit { int pm, pn; };
struct Gemm { const bf16_t* A; const bf16_t* Bt; int lda, ldb, K; };

__device__ __forceinline__ void std_unit(int L, int nM, int nN, Unit& u) {
    const int nwg = nM * nN; int wgid = L; { const int q = nwg / NXCD, r = nwg % NXCD, xcd = wgid % NXCD, off = wgid / NXCD; wgid = (xcd < r ? xcd * (q + 1) : r * (q + 1) + (xcd - r) * q) + off; }
    const int nig = WGM * nN, gid = wgid / nig, fm = gid * WGM, gsz = (nM - fm) < WGM ? (nM - fm) : WGM;
    u.pm = fm + ((wgid % nig) % gsz); u.pn = (wgid % nig) / gsz;
}
struct SchedStd {
    int nM, nN, G, c, lda, ldb;
    __device__ __forceinline__ bool next(int i, Unit& u) const { const int L = i * G + c; if (L >= nM * nN) return false; std_unit(L, nM, nN, u); return true; }
    __device__ __forceinline__ size_t aoff(const Unit& u) const { return (size_t)u.pm * 256 * lda * 2; }
    __device__ __forceinline__ size_t boff(const Unit& u) const { return (size_t)u.pn * 256 * ldb * 2; }
};
struct SchedInproj {
    int G, c;
    __device__ __forceinline__ bool next(int i, Unit& u) const { const int L = i * G + c; if (L >= 512 + 32) return false;
        if (L < 512) std_unit(L, 32, 16, u); else { const int j = L - 512; u.pm = 32 + (j >> 3); u.pn = 8 + (j & 7); } return true; }
    __device__ __forceinline__ size_t aoff(const Unit& u) const { return (size_t)u.pm * 256 * DM * 2; }
    __device__ __forceinline__ size_t boff(const Unit& u) const { return (size_t)u.pn * 256 * DM * 2; }
};
struct SchedPool {
    int G, c;
    __device__ __forceinline__ bool next(int i, Unit& u) const { const int L = i * G + c; if (L >= 128) return false; u.pm = L >> 2; u.pn = L & 3; return true; }
    __device__ __forceinline__ size_t aoff(const Unit& u) const { return ((size_t)u.pm * 256 * POOLW + (size_t)u.pn * 256) * 2; }
    __device__ __forceinline__ size_t boff(const Unit& u) const { return (size_t)u.pn * 65536 * 2; }
};

__device__ __forceinline__ u32x2 pk4(const f32x4 v) { u32x2 o; o.x = pk2(v[0], v[1]); o.y = pk2(v[2], v[3]); return o; }
struct EpiInprojF {
    static constexpr bool PERM = false;
    bf16_t *Pb, *Q, *K, *V; const float* rope;
    __device__ __forceinline__ void operator()(const f32x4 (&acc)[2][2][4][2], const Unit& u, int wr, int wc, int fr, int fq) const {
        const int region = u.pn >> 2, cbase = (u.pn & 3) * 256 + wc * 32 + 4 * fq;
        const bool lat = u.pm < 32;
#pragma unroll
        for (int ai = 0; ai < 2; ++ai)
#pragma unroll
            for (int m = 0; m < 4; ++m) {
                const int lr = 128 * ai + 64 * wr + 16 * m + fr;
                const int b = lat ? (u.pm >> 3) : (u.pm - 32), t = (u.pm & 7) * 256 + lr;
                const size_t grow = (size_t)u.pm * 256 + lr, krow = lat ? ((size_t)b * KVL + CTXL + t) : ((size_t)b * KVL + lr);
                if (region == 0) {
#pragma unroll
                    for (int bj = 0; bj < 2; ++bj)
#pragma unroll
                        for (int n = 0; n < 2; ++n) *(u32x2*)(Pb + grow * POOLW + cbase + 128 * bj + 16 * n) = pk4(acc[ai][bj][m][n]);
                } else if (region == 3) {
#pragma unroll
                    for (int bj = 0; bj < 2; ++bj)
#pragma unroll
                        for (int n = 0; n < 2; ++n) *(u32x2*)(V + krow * ATTW + cbase + 128 * bj + 16 * n) = pk4(acc[ai][bj][m][n]);
                } else if (!lat) {
#pragma unroll
                    for (int bj = 0; bj < 2; ++bj)
#pragma unroll
                        for (int n = 0; n < 2; ++n) *(u32x2*)(K + krow * ATTW + cbase + 128 * bj + 16 * n) = pk4(acc[ai][bj][m][n]);
                } else {
                    const int pos = (wc & 1) ? (t & 63) : (t >> 6);
                    const f32x4 cs = *(const f32x4*)(rope + pos * 16 + 4 * fq), sn = *(const f32x4*)(rope + 1024 + pos * 16 + 4 * fq);
#pragma unroll
                    for (int bj = 0; bj < 2; ++bj) {
                        const f32x4 x1 = acc[ai][bj][m][0], x2 = acc[ai][bj][m][1];
                        f32x4 o1 = x1 * cs - x2 * sn, o2 = x1 * sn + x2 * cs;
                        if (region == 1) { o1 = o1 * QSCALE; o2 = o2 * QSCALE;
                            *(u32x2*)(Q + grow * ATTW + cbase + 128 * bj) = pk4(o1); *(u32x2*)(Q + grow * ATTW + cbase + 128 * bj + 16) = pk4(o2); }
                        else { *(u32x2*)(K + krow * ATTW + cbase + 128 * bj) = pk4(o1); *(u32x2*)(K + krow * ATTW + cbase + 128 * bj + 16) = pk4(o2); }
                    }
                }
            }
    }
};
struct EpiPoolF {
    static constexpr bool PERM = true;
    bf16_t* MIXIN; const float* pool_scale;
    __device__ __forceinline__ void operator()(const f32x4 (&acc)[2][2][4][2], const Unit& u, int wr, int wc, int fr, int fq) const {
        const int col0 = u.pn * 256 + wc * 32 + 8 * fq;
        f32x4 sv[2][2];
#pragma unroll
        for (int bj = 0; bj < 2; ++bj)
#pragma unroll
            for (int n = 0; n < 2; ++n) sv[bj][n] = *(const f32x4*)(pool_scale + col0 + bj * HALF + 4 * n);
#pragma unroll
        for (int ai = 0; ai < 2; ++ai)
#pragma unroll
            for (int m = 0; m < 4; ++m) { bf16_t* rowp = MIXIN + ((size_t)u.pm * 256 + 128 * ai + 64 * wr + 16 * m + fr) * DM + col0;
#pragma unroll
                for (int bj = 0; bj < 2; ++bj) { const f32x4 v0 = acc[ai][bj][m][0] * sv[bj][0], v1 = acc[ai][bj][m][1] * sv[bj][1];
                    u32x4 w; w.x = pk2(v0[0], v0[1]); w.y = pk2(v0[2], v0[3]); w.z = pk2(v1[0], v1[1]); w.w = pk2(v1[2], v1[3]); *(u32x4*)(rowp + bj * HALF) = w; } }
    }
};
struct EpiF32F {
    static constexpr bool PERM = false;
    float* C; int ldc;
    __device__ __forceinline__ void operator()(const f32x4 (&acc)[2][2][4][2], const Unit& u, int wr, int wc, int fr, int fq) const {
        const int col0 = u.pn * 256 + wc * 32 + 4 * fq;
#pragma unroll
        for (int ai = 0; ai < 2; ++ai)
#pragma unroll
            for (int m = 0; m < 4; ++m) { float* rowp = C + ((size_t)u.pm * 256 + 128 * ai + 64 * wr + 16 * m + fr) * ldc + col0;
#pragma unroll
                for (int bj = 0; bj < 2; ++bj)
#pragma unroll
                    for (int n = 0; n < 2; ++n) *(f32x4*)(rowp + bj * HALF + n * 16) = acc[ai][bj][m][n]; }
    }
};
struct EpiSwigluF {
    static constexpr bool PERM = true;
    bf16_t* ACT;
    __device__ __forceinline__ void operator()(const f32x4 (&acc)[2][2][4][2], const Unit& u, int wr, int wc, int fr, int fq) const {
        const int col0 = u.pn * 128 + wc * 32 + 8 * fq;
#pragma unroll
        for (int ai = 0; ai < 2; ++ai)
#pragma unroll
            for (int m = 0; m < 4; ++m) { bf16_t* rowp = ACT + ((size_t)u.pm * 256 + 128 * ai + 64 * wr + 16 * m + fr) * DFF + col0;
                float r[8];
#pragma unroll
                for (int n = 0; n < 2; ++n)
#pragma unroll
                    for (int e = 0; e < 4; ++e) { const float g = acc[ai][0][m][n][e], uu = acc[ai][1][m][n][e];
                        r[4 * n + e] = g * uu * __builtin_amdgcn_rcpf(1.0f + __builtin_amdgcn_exp2f(-1.4426950408889634f * g)); }
                u32x4 w; w.x = pk2(r[0], r[1]); w.y = pk2(r[2], r[3]); w.z = pk2(r[4], r[5]); w.w = pk2(r[6], r[7]); *(u32x4*)rowp = w; }
    }
};

template <class Epi, class Sched, bool ALIGN_EPI>
__device__ __forceinline__ void gemm_phase(LAS unsigned char* lds, const Gemm g, const Sched& S, const Epi& E) {
    const int tid = threadIdx.x, wid = __builtin_amdgcn_readfirstlane(tid >> 6), lane = tid & 63, wr = wid >> 2, wc = wid & 3, fr = lane & 15, fq = lane >> 4;
    const int K = g.K, nt = K / BK;
    unsigned voffA[2], voffB[2];
#pragma unroll
    for (int i = 0; i < 2; ++i) { int R, C; stage_rc(tid * 16 + i * 8192, R, C); const int Rb = Epi::PERM ? ((R & ~31) + perm32(R & 31)) : R;
        voffA[i] = (unsigned)(R * g.lda + C) * 2u; voffB[i] = (unsigned)(Rb * g.ldb + C) * 2u; }
    const size_t kstep = (size_t)(BK * 2);
    const size_t hstepA = (size_t)HALF * g.lda * 2, hstepB = (size_t)HALF * g.ldb * 2;
    const unsigned ldsw = (unsigned)wid * 1024u;
    const int aoff = lds_byte(wr * 64 + fr, fq * 8), boff = lds_byte(wc * 32 + fr, fq * 8);
#define PG8_SA(b, h) (((b) * 2 + (h)) * HTB)
#define PG8_SB(b, h) ((4 + (b) * 2 + (h)) * HTB)
#define PG8_STAGE(bufoff, gbase, voff) do { _Pragma("unroll") for (int _i = 0; _i < 2; ++_i) \
        __builtin_amdgcn_global_load_lds((const unsigned*)((const char*)(gbase) + (voff)[_i]), (LAS unsigned*)(lds + (bufoff) + ldsw + _i * 8192), 16, 0, 0); } while (0)
#define PG8_LDA(dst, b, h) do { _Pragma("unroll") for (int m = 0; m < 4; ++m) _Pragma("unroll") for (int k = 0; k < 2; ++k) dst[m][k] = *(const LAS bf16x8*)(lds + PG8_SA(b, h) + aoff + m * 2048 + k * 1024); } while (0)
#define PG8_LDB(dst, b, h) do { _Pragma("unroll") for (int n = 0; n < 2; ++n) _Pragma("unroll") for (int k = 0; k < 2; ++k) dst[n][k] = *(const LAS bf16x8*)(lds + PG8_SB(b, h) + boff + n * 2048 + k * 1024); } while (0)
#define PG8_MMA(ai, bj, At, Bt) do { __builtin_amdgcn_s_setprio(1); _Pragma("unroll") for (int m = 0; m < 4; ++m) _Pragma("unroll") for (int n = 0; n < 2; ++n) _Pragma("unroll") for (int k = 0; k < 2; ++k) \
        acc[ai][bj][m][n] = __builtin_amdgcn_mfma_f32_16x16x32_bf16(Bt[n][k], At[m][k], acc[ai][bj][m][n], 0, 0, 0); __builtin_amdgcn_s_setprio(0); } while (0)
#define PG8_WAIT_V(n) asm volatile("s_waitcnt vmcnt(" #n ")" ::: "memory")
#define PG8_WAIT_L(n) asm volatile("s_waitcnt lgkmcnt(" #n ")" ::: "memory")
#define PG8_BAR __builtin_amdgcn_s_barrier()
#define PG8_SCHED __builtin_amdgcn_sched_barrier(0)
    Unit cur, nxt; int ui = 0;
    if (!S.next(0, cur)) return;
    f32x4 acc[2][2][4][2];
#pragma unroll
    for (int a = 0; a < 2; ++a)
#pragma unroll
        for (int b = 0; b < 2; ++b)
#pragma unroll
            for (int m = 0; m < 4; ++m)
#pragma unroll
                for (int n = 0; n < 2; ++n) acc[a][b][m][n] = (f32x4){0.f, 0.f, 0.f, 0.f};
    bf16x8 At[4][2], B0[2][2], B1[2][2];
    const char* cA = (const char*)g.A + S.aoff(cur); const char* cB = (const char*)g.Bt + S.boff(cur);
    PG8_STAGE(PG8_SB(0, 0), cB, voffB); PG8_STAGE(PG8_SB(0, 1), cB + hstepB, voffB); PG8_STAGE(PG8_SA(0, 0), cA, voffA); PG8_STAGE(PG8_SA(0, 1), cA + hstepA, voffA);
    if (wr == 1) PG8_BAR;
    PG8_WAIT_V(2); PG8_BAR;
    PG8_STAGE(PG8_SB(1, 0), cB + kstep, voffB); PG8_STAGE(PG8_SA(1, 0), cA + kstep, voffA); PG8_STAGE(PG8_SB(1, 1), cB + hstepB + kstep, voffB);
    PG8_WAIT_V(6); PG8_BAR;
    for (;;) {
        const bool has_next = S.next(ui + 1, nxt);
        const char* nA = has_next ? (const char*)g.A + S.aoff(nxt) : cA; const char* nB = has_next ? (const char*)g.Bt + S.boff(nxt) : cB;
#pragma unroll 1
        for (int t = 0; t < nt; t += 2) {
            const bool last = (t == nt - 2);
            const char* a1 = cA + (size_t)(t + 1) * kstep;
            const char* a2 = last ? nA : cA + (size_t)(t + 2) * kstep; const char* b2 = last ? nB : cB + (size_t)(t + 2) * kstep;
            const char* a3 = a2 + kstep; const char* b3 = b2 + kstep;
            PG8_LDB(B0, 0, 0); PG8_LDB(B1, 0, 1); PG8_SCHED; PG8_LDA(At, 0, 0); PG8_STAGE(PG8_SA(1, 1), a1 + hstepA, voffA);
            PG8_WAIT_V(8); PG8_WAIT_L(0); PG8_BAR; PG8_MMA(0, 0, At, B0); PG8_MMA(0, 1, At, B1); PG8_BAR; PG8_SCHED;
            PG8_LDA(At, 0, 1); PG8_STAGE(PG8_SB(0, 0), b2, voffB); PG8_STAGE(PG8_SB(0, 1), b2 + hstepB, voffB); PG8_STAGE(PG8_SA(0, 0), a2, voffA);
            PG8_WAIT_V(8); PG8_WAIT_L(0); PG8_BAR; PG8_MMA(1, 0, At, B0); PG8_MMA(1, 1, At, B1); PG8_BAR; PG8_SCHED;
            PG8_LDB(B0, 1, 0); PG8_LDB(B1, 1, 1); PG8_SCHED; PG8_LDA(At, 1, 0); PG8_STAGE(PG8_SA(0, 1), a2 + hstepA, voffA);
            PG8_WAIT_V(8); PG8_WAIT_L(0); PG8_BAR; PG8_MMA(0, 0, At, B0); PG8_MMA(0, 1, At, B1); PG8_BAR; PG8_SCHED;
            PG8_LDA(At, 1, 1); PG8_STAGE(PG8_SB(1, 0), b3, voffB); PG8_STAGE(PG8_SB(1, 1), b3 + hstepB, voffB); PG8_STAGE(PG8_SA(1, 0), a3, voffA);
            PG8_WAIT_V(8); PG8_WAIT_L(0); PG8_BAR; PG8_MMA(1, 0, At, B0); PG8_MMA(1, 1, At, B1); PG8_BAR; PG8_SCHED;
        }
        if constexpr (ALIGN_EPI) { if (wr == 0) PG8_BAR; }
        E(acc, cur, wr, wc, fr, fq);
        if (!has_next) break;
#pragma unroll
        for (int a = 0; a < 2; ++a)
#pragma unroll
            for (int b = 0; b < 2; ++b)
#pragma unroll
                for (int m = 0; m < 4; ++m)
#pragma unroll
                    for (int n = 0; n < 2; ++n) acc[a][b][m][n] = (f32x4){0.f, 0.f, 0.f, 0.f};
        cur = nxt; cA = nA; cB = nB; ++ui;
        if constexpr (ALIGN_EPI) { if (wr == 1) PG8_BAR; }
    }
    PG8_WAIT_V(0);
    if constexpr (!ALIGN_EPI) { if (wr == 0) PG8_BAR; }
    PG8_BAR;
#undef PG8_SA
#undef PG8_SB
#undef PG8_STAGE
#undef PG8_LDA
#undef PG8_LDB
#undef PG8_MMA
#undef PG8_WAIT_V
#undef PG8_WAIT_L
#undef PG8_BAR
#undef PG8_SCHED
}
}


namespace att {
typedef float f32x16 __attribute__((ext_vector_type(16)));
typedef short s16x4 __attribute__((ext_vector_type(4)));
constexpr int KVBLK = 64, LDK = ATTW, NT = KVL / KVBLK;
constexpr int SHM_V = 16384, SHM_K = 16384, OFF_V = 0, OFF_K = 2 * SHM_V, OFF_WS = 98304;
constexpr float THRL = 8.0f * 1.4426950408889634f;
#define KSWZ(row, colB) ((row) * 256 + ((colB) ^ (((row) & 7) << 4)))
#define SBAR() __builtin_amdgcn_sched_barrier(0)
__device__ __forceinline__ int crow(int r, int hi) { return (r & 3) + 8 * (r >> 2) + 4 * hi; }
__device__ __forceinline__ unsigned cvtpk(float lo, float hi) { unsigned r; asm volatile("v_cvt_pk_bf16_f32 %0, %1, %2" : "=v"(r) : "v"(lo), "v"(hi)); return r; }
__device__ __forceinline__ void partialSM(f32x16& p0, f32x16& p1, float& m_reg, float& mn, float& alpha) {
    float pmax = p0[0];
#pragma unroll
    for (int r = 1; r < 16; ++r) pmax = fmaxf(pmax, p0[r]);
#pragma unroll
    for (int r = 0; r < 16; ++r) pmax = fmaxf(pmax, p1[r]);
    { auto rr = __builtin_amdgcn_permlane32_swap(__float_as_uint(pmax), __float_as_uint(pmax), false, false);
      pmax = fmaxf(__uint_as_float(rr[0]), __uint_as_float(rr[1])); }
    if (__builtin_expect(__all(pmax - m_reg <= THRL), 1)) { mn = m_reg; alpha = 1.f; }
    else { mn = fmaxf(m_reg, pmax); alpha = __builtin_amdgcn_exp2f(m_reg - mn); m_reg = mn; }
#pragma unroll
    for (int r = 0; r < 16; ++r) p0[r] = p0[r] - mn;
#pragma unroll
    for (int r = 0; r < 16; ++r) p1[r] = p1[r] - mn;
#pragma unroll
    for (int r = 0; r < 16; ++r) p0[r] = __builtin_amdgcn_exp2f(p0[r]);
}
__device__ __forceinline__ void finishSM(f32x16& p0, f32x16& p1, float alpha, float& l_reg, bf16x8& pa0, bf16x8& pa1, bf16x8& pa2, bf16x8& pa3) {
#pragma unroll
    for (int r = 0; r < 16; ++r) p1[r] = __builtin_amdgcn_exp2f(p1[r]);
    float ps = 0;
#pragma unroll
    for (int r = 0; r < 16; ++r) ps += p0[r];
#pragma unroll
    for (int r = 0; r < 16; ++r) ps += p1[r];
    { auto rr = __builtin_amdgcn_permlane32_swap(__float_as_uint(ps), __float_as_uint(ps), false, false);
      ps = __uint_as_float(rr[0]) + __uint_as_float(rr[1]); }
    l_reg = l_reg * alpha + ps;
#define PK4(P, BASE, OUT) do { unsigned a0 = cvtpk(P[BASE + 0], P[BASE + 1]), a1 = cvtpk(P[BASE + 2], P[BASE + 3]);   \
    unsigned b0 = cvtpk(P[BASE + 4], P[BASE + 5]), b1 = cvtpk(P[BASE + 6], P[BASE + 7]);                              \
    auto r0 = __builtin_amdgcn_permlane32_swap(a0, b0, false, false); auto r1 = __builtin_amdgcn_permlane32_swap(a1, b1, false, false); \
    u32x4 w = {r0[0], r1[0], r0[1], r1[1]}; OUT = __builtin_bit_cast(bf16x8, w); } while (0)
    PK4(p0, 0, pa0); PK4(p0, 8, pa1); PK4(p1, 0, pa2); PK4(p1, 8, pa3);
#undef PK4
}
__device__ __forceinline__ void qkt(f32x16& p0, f32x16& p1, const LAS unsigned char* Ks, const bf16x8* qr, int cb0, int r32, int hi) {
    p0 = f32x16{}; p1 = f32x16{};
#pragma unroll
    for (int d0 = 0; d0 < 4; ++d0) { const int cb = cb0 + (d0 * 16 + hi * 8) * 2;
        const bf16x8 b0 = *(const LAS bf16x8*)(Ks + KSWZ(r32, cb));
        const bf16x8 b1 = *(const LAS bf16x8*)(Ks + KSWZ(32 + r32, cb));
        p0 = __builtin_amdgcn_mfma_f32_32x32x16_bf16(b0, qr[d0], p0, 0, 0, 0);
        p1 = __builtin_amdgcn_mfma_f32_32x32x16_bf16(b1, qr[d0], p1, 0, 0, 0); }
}
__device__ __forceinline__ int v_st(int k, int c) { const int kk = (k & ~0xC) | ((k & 4) << 1) | ((k & 8) >> 1); return ((kk >> 3) * 4 + (c >> 5)) * 512 + ((kk & 7) * 32 + (c & 31)) * 2; }
__device__ __forceinline__ int v_rd_base(int lane) { return ((lane & 3) << 3) | (((lane >> 2) & 3) << 6) | (((lane >> 4) & 1) << 5) | (((lane >> 5) & 1) << 8); }
constexpr int v_rd_off(int d0, int ks, int half) { return d0 * 512 + ks * 4096 + half * 2048; }
template <int OFF> __device__ __forceinline__ s16x4 tr_read(int vb) {
    s16x4 r; asm volatile("ds_read_b64_tr_b16 %0, %1 offset:%2" : "=&v"(r) : "v"(vb), "i"(OFF) : "memory"); return r;
}
template <int D0> __device__ __forceinline__ void pv_one(f32x16& od, int vb, bf16x8 pa0, bf16x8 pa1, bf16x8 pa2, bf16x8 pa3) {
    const s16x4 l0 = tr_read<v_rd_off(D0, 0, 0)>(vb), h0 = tr_read<v_rd_off(D0, 0, 1)>(vb), l1 = tr_read<v_rd_off(D0, 1, 0)>(vb), h1 = tr_read<v_rd_off(D0, 1, 1)>(vb);
    const s16x4 l2 = tr_read<v_rd_off(D0, 2, 0)>(vb), h2 = tr_read<v_rd_off(D0, 2, 1)>(vb), l3 = tr_read<v_rd_off(D0, 3, 0)>(vb), h3 = tr_read<v_rd_off(D0, 3, 1)>(vb);
    asm volatile("s_waitcnt lgkmcnt(0)" ::: "memory"); SBAR();
#define PK(L, H) (bf16x8){L[0], L[1], L[2], L[3], H[0], H[1], H[2], H[3]}
    od = __builtin_amdgcn_mfma_f32_32x32x16_bf16(pa0, PK(l0, h0), od, 0, 0, 0);
    od = __builtin_amdgcn_mfma_f32_32x32x16_bf16(pa1, PK(l1, h1), od, 0, 0, 0);
    od = __builtin_amdgcn_mfma_f32_32x32x16_bf16(pa2, PK(l2, h2), od, 0, 0, 0);
    od = __builtin_amdgcn_mfma_f32_32x32x16_bf16(pa3, PK(l3, h3), od, 0, 0, 0);
#undef PK
}
__device__ __forceinline__ void pv_d0(f32x16* o, int vb, bf16x8 pa0, bf16x8 pa1, bf16x8 pa2, bf16x8 pa3) {
    pv_one<0>(o[0], vb, pa0, pa1, pa2, pa3); pv_one<1>(o[1], vb, pa0, pa1, pa2, pa3); pv_one<2>(o[2], vb, pa0, pa1, pa2, pa3); pv_one<3>(o[3], vb, pa0, pa1, pa2, pa3);
}
__device__ __forceinline__ void attn_unit(const Ptrs& P, int b, int h, int qb, LAS unsigned char* lds, float lam) {
    const int tid = threadIdx.x, wid = __builtin_amdgcn_readfirstlane(tid >> 6), lane = tid & 63, r32 = lane & 31, hi = lane >> 5;
    const int pair = wid >> 1, map = wid & 1;
    const bf16_t* Kh = (const bf16_t*)(P.ws + WS_K) + (size_t)b * KVL * ATTW + h * VHD;
    const bf16_t* Vh = (const bf16_t*)(P.ws + WS_V) + (size_t)b * KVL * ATTW + h * VHD;
    const size_t qrow = (size_t)b * SEQ + qb * 128 + pair * 32 + r32;
    LAS float* wsf = (LAS float*)(lds + OFF_WS) + wid * 64; LAS float* li_l = wsf; LAS float* al_l = wsf + 32;
    float m_reg = -1e30f, l_reg = 0; f32x16 o[4] = {}; bf16x8 qr[4];
    { const bf16_t* Qw = (const bf16_t*)(P.ws + WS_Q) + qrow * ATTW + h * VHD + map * 64 + hi * 8;
#pragma unroll
      for (int d0 = 0; d0 < 4; ++d0) qr[d0] = *(const bf16x8*)(Qw + d0 * 16); }
    const int cb0 = map * 128;
    const int sr = tid >> 4, sc = (tid & 15) * 8, vst0 = v_st(sr, sc), vst1 = v_st(32 + sr, sc);
    const int vb0 = (int)(unsigned)(uintptr_t)(lds + OFF_V) + v_rd_base(lane);
    struct { bf16x8 vs0, vs1, ks0, ks1; } sr_[2];
#define SLOAD(i, k0) do { sr_[i].vs0 = *(const bf16x8*)(&Vh[(size_t)((k0) + sr) * LDK + sc]); sr_[i].vs1 = *(const bf16x8*)(&Vh[(size_t)((k0) + 32 + sr) * LDK + sc]); \
    sr_[i].ks0 = *(const bf16x8*)(&Kh[(size_t)((k0) + sr) * LDK + sc]); sr_[i].ks1 = *(const bf16x8*)(&Kh[(size_t)((k0) + 32 + sr) * LDK + sc]); } while (0)
#define SWRITE(bb, i) do { *(LAS bf16x8*)(lds + OFF_V + (bb) * SHM_V + vst0) = sr_[i].vs0; *(LAS bf16x8*)(lds + OFF_V + (bb) * SHM_V + vst1) = sr_[i].vs1; const int kc = sc * 2; \
    *(LAS bf16x8*)(lds + OFF_K + (bb) * SHM_K + KSWZ(sr, kc)) = sr_[i].ks0; *(LAS bf16x8*)(lds + OFF_K + (bb) * SHM_K + KSWZ(32 + sr, kc)) = sr_[i].ks1; } while (0)
#define SWAIT() asm volatile("s_waitcnt vmcnt(4)" ::: "memory")
#define RESC(a) do { if (__any((a) < 1.f)) { if (hi == 0) al_l[r32] = (a); asm volatile("s_waitcnt lgkmcnt(0)" ::: "memory"); \
    _Pragma("unroll") for (int d = 0; d < 4; ++d) _Pragma("unroll") for (int r = 0; r < 16; ++r) o[d][r] *= al_l[crow(r, hi)]; } } while (0)
    f32x16 pA0, pA1, pB0, pB1; float mnA, mnB, alA, alB; bf16x8 pa0, pa1, pa2, pa3;
    const LAS unsigned char* K0 = lds + OFF_K; const LAS unsigned char* K1 = lds + OFF_K + SHM_K;
    SLOAD(0, 0); asm volatile("s_waitcnt vmcnt(0)" ::: "memory"); SWRITE(0, 0); __syncthreads();
    qkt(pA0, pA1, K0, qr, cb0, r32, hi); partialSM(pA0, pA1, m_reg, mnA, alA);
    SLOAD(1, KVBLK); SLOAD(0, 2 * KVBLK);
    SWAIT(); SWRITE(1, 1); __syncthreads();
    for (int j = 1; j + 1 < NT; j += 2) {
        SBAR(); qkt(pB0, pB1, K1, qr, cb0, r32, hi);
        finishSM(pA0, pA1, alA, l_reg, pa0, pa1, pa2, pa3); SBAR();
        SLOAD(1, (j + 2) * KVBLK); SBAR();
        pv_d0(o, vb0, pa0, pa1, pa2, pa3); partialSM(pB0, pB1, m_reg, mnB, alB);
        __syncthreads(); SWAIT(); SWRITE(0, 0);
        RESC(alB); __syncthreads();
        SBAR(); qkt(pA0, pA1, K0, qr, cb0, r32, hi);
        finishSM(pB0, pB1, alB, l_reg, pa0, pa1, pa2, pa3); SBAR();
        if (j + 3 < NT) SLOAD(0, (j + 3) * KVBLK); SBAR();
        pv_d0(o, vb0 + SHM_V, pa0, pa1, pa2, pa3); partialSM(pA0, pA1, m_reg, mnA, alA);
        __syncthreads(); SWAIT(); SWRITE(1, 1);
        RESC(alA); __syncthreads();
    }
    SBAR(); qkt(pB0, pB1, K1, qr, cb0, r32, hi);
    finishSM(pA0, pA1, alA, l_reg, pa0, pa1, pa2, pa3); SBAR();
    pv_d0(o, vb0, pa0, pa1, pa2, pa3); partialSM(pB0, pB1, m_reg, mnB, alB);
    __syncthreads(); RESC(alB);
    finishSM(pB0, pB1, alB, l_reg, pa0, pa1, pa2, pa3); SBAR();
    pv_d0(o, vb0 + SHM_V, pa0, pa1, pa2, pa3);
    if (hi == 0) li_l[r32] = l_reg; asm volatile("s_waitcnt lgkmcnt(0)" ::: "memory");
    const float osc = map ? lam : 1.0f;
#pragma unroll
    for (int r = 0; r < 16; ++r) { const float rl = __builtin_amdgcn_rcpf(li_l[crow(r, hi)]) * osc;
#pragma unroll
        for (int d0 = 0; d0 < 4; ++d0) o[d0][r] *= rl; }
    __syncthreads();
    LAS float* X = (LAS float*)(lds + pair * 17408);
    if (map == 1) {
#pragma unroll
        for (int d0 = 0; d0 < 4; ++d0)
#pragma unroll
            for (int r = 0; r < 16; ++r) X[(d0 * 16 + r) * 64 + lane] = o[d0][r];
    }
    __syncthreads();
    if (map == 0) {
#pragma unroll
        for (int d0 = 0; d0 < 4; ++d0)
#pragma unroll
            for (int r = 0; r < 16; ++r) o[d0][r] -= X[(d0 * 16 + r) * 64 + lane];
        asm volatile("s_waitcnt lgkmcnt(0)" ::: "memory");
        LAS float* Yw = X + (4 * hi) * 132 + r32;
#pragma unroll
        for (int d0 = 0; d0 < 4; ++d0)
#pragma unroll
            for (int r = 0; r < 16; ++r) Yw[((r & 3) + 8 * (r >> 2)) * 132 + 32 * d0] = o[d0][r];
        asm volatile("s_waitcnt lgkmcnt(0)" ::: "memory");
        const LAS float* Yr = X + r32 * 132 + hi * 64;
        float ss = 0.f;
#pragma unroll
        for (int jj = 0; jj < 16; ++jj) { const f32x4 v = *(const LAS f32x4*)(Yr + jj * 4); ss += (v.x * v.x + v.y * v.y) + (v.z * v.z + v.w * v.w); }
        ss += __shfl_xor(ss, 32);
        const float inv = (1.0f - LAMBDA_INIT) / sqrtf(ss * (1.0f / VHD) + EPS);
        bf16_t* orow = (bf16_t*)(P.ws + WS_MIXIN) + qrow * DM + POOLW + h * VHD + hi * 64;
        const float* gs = P.g_subln + hi * 64;
#pragma unroll
        for (int jj = 0; jj < 16; jj += 2) { const f32x4 g0 = *(const f32x4*)(gs + jj * 4), g1 = *(const f32x4*)(gs + jj * 4 + 4);
            const f32x4 a = *(const LAS f32x4*)(Yr + jj * 4) * inv * g0, c = *(const LAS f32x4*)(Yr + jj * 4 + 4) * inv * g1;
            u32x4 w; w.x = pk2(a.x, a.y); w.y = pk2(a.z, a.w); w.z = pk2(c.x, c.y); w.w = pk2(c.z, c.w); *(u32x4*)(orow + jj * 4) = w; }
    }
    __syncthreads();
#undef SLOAD
#undef SWRITE
#undef SWAIT
#undef RESC
}
__device__ __forceinline__ void attn_phase(const Ptrs& P, int bid, int G, LAS unsigned char* lds) {
    const float lam = ((const float*)(P.ws + WS_ROPE))[2048];
    const int vcu = (G % 8 == 0) ? (bid % 8) * (G / 8) + bid / 8 : bid;
    for (int u = vcu; u < NB * NH * (SEQ / 128); u += G) { const int bh = u >> 4, qb = u & 15; attn_unit(P, bh >> 3, bh & 7, qb, lds, lam); }
}
#undef KSWZ
#undef SBAR
}

#define XB_TMO      128
#define XB_XCNT(j)  (256  + 64 * (j))
#define XB_XSUB(j)  (1280 + 64 * (j))
#define XB_XGEN(j)  (2304 + 64 * (j))
#define XB_TOP      3328
#define XB_TOPGEN   3392
#define XCD_BAR_WORDS 3456
#define XB_SPIN_CAP (1u << 18)
__device__ __forceinline__ unsigned xb_ld(unsigned* p)              { return __hip_atomic_load(p, __ATOMIC_RELAXED, __HIP_MEMORY_SCOPE_AGENT); }
__device__ __forceinline__ unsigned xb_add(unsigned* p, unsigned v) { return __hip_atomic_fetch_add(p, v, __ATOMIC_RELAXED, __HIP_MEMORY_SCOPE_AGENT); }
__device__ __forceinline__ unsigned xb_xcc_id() { return (unsigned)__builtin_amdgcn_s_getreg((3 << 11) | 20) & 0xFu; }
#define XB_SPIN(cond, bar) do { unsigned _sp = 0; while (cond) { __builtin_amdgcn_s_sleep(1); \
    if ((++_sp & 255u) == 0u) { if (xb_ld(&(bar)[XB_TMO])) break; if (_sp > XB_SPIN_CAP) { atomicAdd(&(bar)[XB_TMO], 1u); break; } } } } while (0)
struct XcdBarrier { unsigned* bar; unsigned x; volatile LAS unsigned* st; };
__device__ __forceinline__ XcdBarrier xcd_barrier_post(unsigned* bar, volatile LAS unsigned* st) {
    XcdBarrier b; b.bar = bar; b.x = xb_xcc_id(); b.st = st;
    if (threadIdx.x == 0) (void)xb_add(&bar[XB_XCNT(b.x)], 1u);
    return b;
}
__device__ __forceinline__ void xcd_barrier_complete(unsigned* bar, unsigned x, unsigned& nloc, unsigned& nx) {
    const unsigned G = gridDim.x * gridDim.y * gridDim.z;
    unsigned sum, cnt, mine, sp = 0u;
    for (;;) {
        sum = 0u; cnt = 0u; mine = 0u;
#pragma unroll
        for (unsigned j = 0; j < 16; ++j) { const unsigned c = xb_ld(&bar[XB_XCNT(j)]); sum += c; cnt += (c > 0u) ? 1u : 0u; mine = (j == x) ? c : mine; }
        if (sum == G) break;
        __builtin_amdgcn_s_sleep(1);
        if ((++sp & 255u) == 0u) { if (xb_ld(&bar[XB_TMO])) break; if (sp > XB_SPIN_CAP) { atomicAdd(&bar[XB_TMO], 1u); break; } }
    }
    nloc = mine > 0u ? mine : 1u; nx = cnt > 0u ? cnt : 1u;
}
__device__ __forceinline__ void xcd_barrier(const XcdBarrier& b) {
    asm volatile("s_waitcnt vmcnt(0)" ::: "memory");
    __syncthreads();
    if (threadIdx.x == 0) {
        unsigned* bar = b.bar;
        __builtin_amdgcn_s_waitcnt(0);
        unsigned nloc = b.st[0], nx = b.st[1];
        if (nloc == 0u) { xcd_barrier_complete(bar, b.x, nloc, nx); b.st[0] = nloc; b.st[1] = nx; }
        const unsigned old = xb_add(&bar[XB_XSUB(b.x)], 1u);
        const unsigned gen = old / nloc;
        if (old + 1u == (gen + 1u) * nloc) {
            __builtin_amdgcn_fence(__ATOMIC_RELEASE, "agent");
            asm volatile("s_waitcnt vmcnt(0)" ::: "memory");
            const unsigned og = xb_add(&bar[XB_TOP], 1u);
            const unsigned tg = og / nx;
            if (og + 1u == (tg + 1u) * nx) xb_add(&bar[XB_TOPGEN], 1u);
            else XB_SPIN(xb_ld(&bar[XB_TOPGEN]) == tg, bar);
            __builtin_amdgcn_fence(__ATOMIC_ACQUIRE, "agent");
            xb_add(&bar[XB_XGEN(b.x)], 1u);
            asm volatile("s_waitcnt vmcnt(0)" ::: "memory");
        } else {
            XB_SPIN(xb_ld(&bar[XB_XGEN(b.x)]) == gen, bar);
            __builtin_amdgcn_fence(__ATOMIC_ACQUIRE, "agent");
            asm volatile("s_waitcnt vmcnt(0)" ::: "memory");
        }
    }
    __syncthreads();
}

constexpr int RING_BYTES = 131072, LDSCTL_OFF = RING_BYTES, MISC_OFF = LDSCTL_OFF + 320, LDS_BYTES = 147456;
constexpr int CW_BAR = 4096;
constexpr int N_PHASES = 10;
#ifndef FAST_ATTN
#define FAST_ATTN 1
#endif
struct Args { Ptrs P; int ph_lo, ph_hi, li, pad; };
__global__ void __launch_bounds__(512, 2) mega_fwd(Args args) {
    extern __shared__ __attribute__((aligned(16))) unsigned char lds_raw[];
    LAS unsigned char* lds = (LAS unsigned char*)lds_raw;
    const Ptrs& P = args.P;
    const int tid = threadIdx.x, G = gridDim.x, bid = blockIdx.x;
    for (int u = tid; u < (LDS_BYTES - LDSCTL_OFF) / 4; u += 512) ((LAS unsigned*)(lds + LDSCTL_OFF))[u] = 0u;
    __syncthreads();
    volatile LAS unsigned* MISC = (volatile LAS unsigned*)(lds + MISC_OFF);
    unsigned* ctl = (unsigned*)(P.ws + WS_CTL);
    XcdBarrier bar = xcd_barrier_post(ctl + CW_BAR + args.li * XCD_BAR_WORDS, MISC + 8);
    const int lo = args.ph_lo, hi = args.ph_hi;
#ifdef PHASE_MASK
#define IN(k) (lo <= (k) && (k) < hi && ((PHASE_MASK >> (k)) & 1))
#else
#define IN(k) (lo <= (k) && (k) < hi)
#endif
#define SEAM(k) do { if (IN(k) && IN((k) + 1)) xcd_barrier(bar); } while (0)
    unsigned char* ws = P.ws;
    bf16_t* H = (bf16_t*)(ws + WS_H);
    if (IN(0)) { p0_prologue(P, bid, G, lds); SEAM(0); }
    if (IN(1)) { p1_rows(P, bid, G, lds); SEAM(1); }
    if (IN(2)) {
        pg8::Gemm g{H, (const bf16_t*)(ws + WS_WIN), DM, DM, DM}; pg8::SchedInproj S{G, bid};
        pg8::EpiInprojF E{(bf16_t*)(ws + WS_P), (bf16_t*)(ws + WS_Q), (bf16_t*)(ws + WS_K), (bf16_t*)(ws + WS_V), (const float*)(ws + WS_ROPE)};
        pg8::gemm_phase<pg8::EpiInprojF, pg8::SchedInproj, true>(lds, g, S, E);
        SEAM(2);
    }
    if (IN(3)) { p3_dp(P, bid, G);
#if FAST_ATTN
        att::attn_phase(P, bid, G, lds);
#endif
        SEAM(3); }
    if (IN(4)) {
        pg8::Gemm g{(const bf16_t*)(ws + WS_DP), (const bf16_t*)(ws + WS_WPOOL), POOLW, 256, 256}; pg8::SchedPool S{G, bid};
        pg8::EpiPoolF E{(bf16_t*)(ws + WS_MIXIN), P.pool_scale};
        pg8::gemm_phase<pg8::EpiPoolF, pg8::SchedPool, true>(lds, g, S, E);
        SEAM(4);
    }
    if (IN(5)) {
        pg8::Gemm g{(const bf16_t*)(ws + WS_MIXIN), (const bf16_t*)(ws + WS_WOUT), DM, DM, DM}; pg8::SchedStd S{32, 8, G, bid, DM, DM};
        pg8::EpiF32F E{(float*)(ws + WS_MIX), DM};
        pg8::gemm_phase<pg8::EpiF32F, pg8::SchedStd, true>(lds, g, S, E);
        SEAM(5);
    }
    if (IN(6)) { p6_rows(P, bid, G, lds); SEAM(6); }
    if (IN(7)) {
        pg8::Gemm g{H, (const bf16_t*)(ws + WS_WGU), DM, DM, DM}; pg8::SchedStd S{32, 44, G, bid, DM, DM};
        pg8::EpiSwigluF E{(bf16_t*)(ws + WS_ACT)};
        pg8::gemm_phase<pg8::EpiSwigluF, pg8::SchedStd, true>(lds, g, S, E);
        SEAM(7);
    }
    if (IN(8)) {
        pg8::Gemm g{(const bf16_t*)(ws + WS_ACT), (const bf16_t*)(ws + WS_WDN), DFF, DFF, DFF}; pg8::SchedStd S{32, 8, G, bid, DFF, DFF};
        pg8::EpiF32F E{(float*)(ws + WS_MIX), DM};
        pg8::gemm_phase<pg8::EpiF32F, pg8::SchedStd, true>(lds, g, S, E);
        SEAM(8);
    }
    if (IN(9)) { p9_rows(P, bid, G, lds); }
#undef IN
#undef SEAM
}

extern "C" void kernel_launch(void* const* d_in, const int* in_sizes, int n_in, void* d_out, int out_size, void* d_ws, size_t ws_size, hipStream_t stream) {
    static int ok = 0;
    if (ok == 0) {
        if (n_in != 21 || in_sizes[0] != MLAT * DM || out_size != MLAT * DM || ws_size < WS_END) {
            fprintf(stderr, "kernel_launch: unexpected shapes: n_in %d in0 %d out %d ws %zu (need >= %zu)\n", n_in, n_in > 0 ? in_sizes[0] : -1, out_size, ws_size, (size_t)WS_END); ok = -1; return; }
        if (hipFuncSetAttribute((const void*)mega_fwd, hipFuncAttributeMaxDynamicSharedMemorySize, LDS_BYTES) != hipSuccess) { fprintf(stderr, "kernel_launch: hipFuncSetAttribute failed\n"); ok = -1; return; }
        int dev = 0, cus = 0, per_cu = 0;
        if (hipGetDevice(&dev) != hipSuccess || hipDeviceGetAttribute(&cus, hipDeviceAttributeMultiprocessorCount, dev) != hipSuccess) { ok = -1; return; }
        if (hipOccupancyMaxActiveBlocksPerMultiprocessor(&per_cu, (const void*)mega_fwd, 512, LDS_BYTES) != hipSuccess || per_cu < 1) fprintf(stderr, "kernel_launch: occupancy query reports %d blocks per CU\n", per_cu);
        (void)hipGetLastError();
        if (cus != 256) fprintf(stderr, "kernel_launch: %d CUs (built for 256)\n", cus);
        ok = cus;
    }
    if (ok < 0) return;
    const int grid = ok;
    Ptrs P{};
#define IN_(i) ((const float*)d_in[i])
    P.x = IN_(0); P.c = IN_(1); P.ctx = IN_(2); P.c_ctx = IN_(3); P.w_ada = IN_(4); P.b_ada = IN_(5); P.g_pre_mix = IN_(6); P.g_post_mix = IN_(7);
    P.g_pre_ffn = IN_(8); P.g_post_ffn = IN_(9); P.w_in = IN_(10); P.w_pool = IN_(11); P.pool_scale = IN_(12); P.lq1 = IN_(13); P.lk1 = IN_(14);
    P.lq2 = IN_(15); P.lk2 = IN_(16); P.g_subln = IN_(17); P.w_out = IN_(18); P.w_gu = IN_(19); P.w_dn = IN_(20);
#undef IN_
    P.out = (float*)d_out; P.ws = (unsigned char*)d_ws;
    if (hipMemsetAsync((char*)d_ws + WS_CTL, 0, CTL_ZERO_BYTES, stream) != hipSuccess) { fprintf(stderr, "kernel_launch: hipMemsetAsync failed\n"); return; }
    Args a{}; a.P = P;
#if FAST_ATTN
    a.ph_lo = 0; a.ph_hi = N_PHASES; a.li = 0;
    hipLaunchKernelGGL(mega_fwd, dim3(grid), dim3(512), LDS_BYTES, stream, a);
#else
    a.ph_lo = 0; a.ph_hi = 4; a.li = 0;
    hipLaunchKernelGGL(mega_fwd, dim3(grid), dim3(512), LDS_BYTES, stream, a);
    hipLaunchKernelGGL(k_sattn, dim3(MLAT / 4, NH), dim3(256), 0, stream, P);
    a.ph_lo = 4; a.ph_hi = N_PHASES; a.li = 1;
    hipLaunchKernelGGL(mega_fwd, dim3(grid), dim3(512), LDS_BYTES, stream, a);
#endif
    const hipError_t le = hipPeekAtLastError();
    if (le != hipSuccess) fprintf(stderr, "kernel_launch: launch failed: %s\n", hipGetErrorName(le));
}
```

```cpp
#include <hip/hip_runtime.h>
#include <cstdio>
#include <cstdint>

#define GAS __attribute__((address_space(1)))
#define LAS __attribute__((address_space(3)))
typedef unsigned short bf16_t;
typedef short bf16x8 __attribute__((ext_vector_type(8)));
typedef float f32x4 __attribute__((ext_vector_type(4)));
typedef float f32x2 __attribute__((ext_vector_type(2)));
typedef unsigned u32x4 __attribute__((ext_vector_type(4)));
typedef unsigned u32x2 __attribute__((ext_vector_type(2)));

constexpr int DM = 2048, NB = 4, SEQ = 2048, CTXL = 256, MLAT = NB * SEQ, MCTX = NB * CTXL, MALL = MLAT + MCTX;
constexpr int NIN = 4096, POOLW = 1024, ATTW = 1024, NH = 8, VHD = 128, QKD = 64, DFF = 5632, NMOD = 6 * DM, KVL = CTXL + SEQ;
constexpr int NBM = NB + 1;
constexpr int KSLAB = 8;
constexpr float EPS = 1e-6f;
constexpr float QSCALE = 0.125f * 1.4426950408889634f;
constexpr float LAMBDA_INIT = 0.2f;

constexpr size_t MiB = 1u << 20;
constexpr size_t WS_CTL = 0, CTL_ZERO_BYTES = 1 * MiB;
constexpr size_t WS_MODP = 1 * MiB;
constexpr size_t WS_MOD = 3 * MiB;
constexpr size_t WS_ROPE = 3 * MiB + 512 * 1024;
constexpr size_t WS_WPOOL = 4 * MiB;
constexpr size_t WS_WIN = 8 * MiB;
constexpr size_t WS_WOUT = 24 * MiB;
constexpr size_t WS_WGU = 32 * MiB;
constexpr size_t WS_WDN = 76 * MiB;
constexpr size_t WS_H = 98 * MiB;
constexpr size_t WS_P = 134 * MiB;
constexpr size_t WS_Q = 150 * MiB;
constexpr size_t WS_K = 166 * MiB;
constexpr size_t WS_V = 184 * MiB;
constexpr size_t WS_DP = 202 * MiB;
constexpr size_t WS_MIXIN = 218 * MiB;
constexpr size_t WS_ACT = 134 * MiB;
constexpr size_t WS_MIX = 250 * MiB;
constexpr size_t WS_END = 314 * MiB;

struct Ptrs {
    const float *x, *c, *ctx, *c_ctx, *w_ada, *b_ada, *g_pre_mix, *g_post_mix, *g_pre_ffn, *g_post_ffn, *w_in, *w_pool, *pool_scale;
    const float *lq1, *lk1, *lq2, *lk2, *g_subln, *w_out, *w_gu, *w_dn;
    float* out; unsigned char* ws;
};

__device__ __forceinline__ unsigned f2bf(float f) { unsigned u = __builtin_bit_cast(unsigned, f); return (u + 0x7fffu + ((u >> 16) & 1u)) >> 16; }
__device__ __forceinline__ unsigned pk2(float lo, float hi) { return f2bf(lo) | (f2bf(hi) << 16); }
__device__ __forceinline__ float bf2f(unsigned short b) { return __builtin_bit_cast(float, (unsigned)b << 16); }
__device__ __forceinline__ float wave_sum(float v) {
#pragma unroll
    for (int o = 1; o < 64; o <<= 1) v += __shfl_xor(v, o);
    return v;
}
__device__ __forceinline__ float wave_max(float v) {
#pragma unroll
    for (int o = 1; o < 64; o <<= 1) v = fmaxf(v, __shfl_xor(v, o));
    return v;
}

__device__ __forceinline__ void p0_gemv_item(const Ptrs& P, int it, LAS unsigned char* lds, int tid) {
    const int ks = it / 32, ns = it % 32;
    LAS float* s_silu = (LAS float*)lds;
    LAS f32x4* red = (LAS f32x4*)(lds + 8192);
    if (tid < 256) {
#pragma unroll
        for (int b = 0; b < NBM; ++b) {
            const float v = (b < NB) ? P.c[b * DM + ks * 256 + tid] : P.c_ctx[ks * 256 + tid];
            s_silu[b * 256 + tid] = v / (1.0f + expf(-v));
        }
    }
    __syncthreads();
    if (tid < 384) {
        const int col4 = tid % 96, ksub = tid / 96;
        f32x4 acc[NBM];
#pragma unroll
        for (int b = 0; b < NBM; ++b) acc[b] = (f32x4){0.f, 0.f, 0.f, 0.f};
        const float* wp = P.w_ada + (size_t)(ks * 256 + ksub * 64) * NMOD + ns * 384 + col4 * 4;
#pragma unroll 8
        for (int kk = 0; kk < 64; ++kk) {
            const f32x4 w = *(const f32x4*)(wp + (size_t)kk * NMOD);
#pragma unroll
            for (int b = 0; b < NBM; ++b) acc[b] += w * s_silu[b * 256 + ksub * 64 + kk];
        }
#pragma unroll
        for (int b = 0; b < NBM; ++b) red[(ksub * NBM + b) * 96 + col4] = acc[b];
    }
    __syncthreads();
    if (tid < NBM * 96) {
        const int b = tid / 96, c4 = tid % 96;
        f32x4 s = red[(0 * NBM + b) * 96 + c4];
        s += red[(1 * NBM + b) * 96 + c4]; s += red[(2 * NBM + b) * 96 + c4]; s += red[(3 * NBM + b) * 96 + c4];
        float* modp = (float*)(P.ws + WS_MODP);
        *(f32x4*)(modp + ((size_t)ks * NBM + b) * NMOD + ns * 384 + c4 * 4) = s;
    }
    __syncthreads();
}
__device__ __forceinline__ void p0_transpose_item(const float* W, int K, int N, bf16_t* WT, int k0, int n0, int drow0, LAS float* scr, int lane) {
#pragma unroll 8
    for (int i = 0; i < 32; ++i) { const int kk = 2 * i + (lane >> 5); scr[kk * 33 + (lane & 31)] = W[(size_t)(k0 + kk) * N + n0 + (lane & 31)]; }
    asm volatile("s_waitcnt lgkmcnt(0)" ::: "memory");
    const int c = lane & 7;
#pragma unroll
    for (int j = 0; j < 4; ++j) { const int n = (lane >> 3) + 8 * j; const LAS float* s = scr + (8 * c) * 33 + n;
        u32x4 o; o.x = pk2(s[0 * 33], s[1 * 33]); o.y = pk2(s[2 * 33], s[3 * 33]); o.z = pk2(s[4 * 33], s[5 * 33]); o.w = pk2(s[6 * 33], s[7 * 33]);
        *(u32x4*)(WT + (size_t)(drow0 + n) * K + k0 + 8 * c) = o; }
    asm volatile("s_waitcnt lgkmcnt(0)" ::: "memory");
}
constexpr int I_IN = (DM / 64) * (NIN / 32), I_OUT = (DM / 64) * (DM / 32), I_GU = (DM / 64) * (2 * DFF / 32), I_DN = (DFF / 64) * (DM / 32), I_PL = 4 * (256 / 64) * (256 / 32);
__device__ __forceinline__ void convert_items(const Ptrs& P, int first, int count, int wk, int nwk, LAS unsigned char* lds) {
    const int lane = threadIdx.x & 63, wave = threadIdx.x >> 6;
    LAS float* scr = (LAS float*)(lds + wave * 16384);
    for (int it = first + wk; it < first + count; it += nwk) {
        int r = it;
        if (r < I_IN) { const int nblk = NIN / 32, kb = r / nblk, nb = r % nblk; p0_transpose_item(P.w_in, DM, NIN, (bf16_t*)(P.ws + WS_WIN), 64 * kb, 32 * nb, 32 * nb, scr, lane); continue; } r -= I_IN;
        if (r < I_OUT) { const int nblk = DM / 32, kb = r / nblk, nb = r % nblk; p0_transpose_item(P.w_out, DM, DM, (bf16_t*)(P.ws + WS_WOUT), 64 * kb, 32 * nb, 32 * nb, scr, lane); continue; } r -= I_OUT;
        if (r < I_GU) { const int nblk = 2 * DFF / 32, kb = r / nblk, nb = r % nblk; const int n0 = 32 * nb, bj = n0 / DFF, rem = n0 % DFF, pn = rem / 128, cl = rem % 128;
            p0_transpose_item(P.w_gu, DM, 2 * DFF, (bf16_t*)(P.ws + WS_WGU), 64 * kb, n0, 256 * pn + 128 * bj + cl, scr, lane); continue; } r -= I_GU;
        if (r < I_DN) { const int nblk = DM / 32, kb = r / nblk, nb = r % nblk; p0_transpose_item(P.w_dn, DFF, DM, (bf16_t*)(P.ws + WS_WDN), 64 * kb, 32 * nb, 32 * nb, scr, lane); continue; } r -= I_DN;
        { const int g = r / 32, rr = r % 32, kb = rr / 8, nb = rr % 8; p0_transpose_item(P.w_pool + (size_t)g * 65536, 256, 256, (bf16_t*)(P.ws + WS_WPOOL) + (size_t)g * 65536, 64 * kb, 32 * nb, 32 * nb, scr, lane); }
    }
}
__device__ __forceinline__ void p0_prologue(const Ptrs& P, int bid, int G, LAS unsigned char* lds) {
    const int tid = threadIdx.x, lane = tid & 63, wave = tid >> 6;
    for (int it = bid; it < KSLAB * 32; it += G) p0_gemv_item(P, it, lds, tid);
    if (bid == 0) {
        float* rope = (float*)(P.ws + WS_ROPE);
        for (int idx = tid; idx < 64 * 16; idx += 512) {
            const int pos = idx / 16, i = idx % 16;
            const float inv = powf(10000.0f, -(float)i / 16.0f);
            const float ang = (float)pos * inv;
            rope[idx] = cosf(ang); rope[1024 + idx] = sinf(ang);
        }
        if (wave == 0) {
            const float s1 = wave_sum(P.lq1[lane] * P.lk1[lane]), s2 = wave_sum(P.lq2[lane] * P.lk2[lane]);
            if (lane == 0) rope[2048] = expf(s1) - expf(s2) + LAMBDA_INIT;
        }
    }
    __syncthreads();
    convert_items(P, 0, I_IN, bid * 8 + wave, G * 8, lds);
    convert_items(P, I_IN + I_OUT + I_GU + I_DN, I_PL, bid * 8 + wave, G * 8, lds);
}

__device__ __forceinline__ void row_modnorm(const float* xrow, bf16_t* orow, const LAS float* a, const LAS float* s, int lane) {
    f32x4 v[8]; float ss = 0.f;
#pragma unroll
    for (int j = 0; j < 8; ++j) { v[j] = *((const f32x4*)xrow + lane + 64 * j); ss += (v[j].x * v[j].x + v[j].y * v[j].y) + (v[j].z * v[j].z + v[j].w * v[j].w); }
    const float inv = 1.0f / sqrtf(wave_sum(ss) * (1.0f / DM) + EPS);
#pragma unroll
    for (int j = 0; j < 8; ++j) { const f32x4 av = *((const LAS f32x4*)a + lane + 64 * j), sv = *((const LAS f32x4*)s + lane + 64 * j);
        const f32x4 y = v[j] * inv * av + sv; u32x2 o; o.x = pk2(y.x, y.y); o.y = pk2(y.z, y.w); *((u32x2*)orow + lane + 64 * j) = o; }
}
__device__ __forceinline__ void p1_rows(const Ptrs& P, int bid, int G, LAS unsigned char* lds) {
    const int tid = threadIdx.x, lane = tid & 63, wave = tid >> 6;
    const float* modp = (const float*)(P.ws + WS_MODP); float* mod = (float*)(P.ws + WS_MOD);
    for (int e = bid * 512 + tid; e < NBM * NMOD; e += G * 512) { float s = P.b_ada[e % NMOD];
#pragma unroll
        for (int k = 0; k < KSLAB; ++k) s += modp[(size_t)k * NBM * NMOD + e];
        mod[e] = s; }
    LAS float* la = (LAS float*)lds; LAS float* ls = (LAS float*)(lds + 8192);
    bf16_t* H = (bf16_t*)(P.ws + WS_H);
    for (int rb = bid; rb < 256 + 256; rb += G) {
        const bool isctx = rb >= 256; const int b = isctx ? NB : rb / 64;
        __syncthreads();
        for (int k = tid; k < DM; k += 512) { float sh = P.b_ada[k], sc = P.b_ada[DM + k];
#pragma unroll
            for (int s = 0; s < KSLAB; ++s) { sh += modp[((size_t)s * NBM + b) * NMOD + k]; sc += modp[((size_t)s * NBM + b) * NMOD + DM + k]; }
            la[k] = P.g_pre_mix[k] * (1.0f + sc); ls[k] = sh; }
        __syncthreads();
        if (!isctx) { for (int i = 0; i < 4; ++i) { const int row = rb * 32 + wave * 4 + i; row_modnorm(P.x + (size_t)row * DM, H + (size_t)row * DM, la, ls, lane); } }
        else if (wave < 4) { const int row = (rb - 256) * 4 + wave; row_modnorm(P.ctx + (size_t)row * DM, H + (size_t)(MLAT + row) * DM, la, ls, lane); }
    }
}
__device__ __forceinline__ void p6_rows(const Ptrs& P, int bid, int G, LAS unsigned char* lds) {
    const int tid = threadIdx.x, lane = tid & 63, wave = tid >> 6;
    const float* mod = (const float*)(P.ws + WS_MOD); const float* MIX = (const float*)(P.ws + WS_MIX);
    LAS float* lg = (LAS float*)lds; LAS float* la = (LAS float*)(lds + 8192); LAS float* ls = (LAS float*)(lds + 16384);
    bf16_t* H = (bf16_t*)(P.ws + WS_H);
    for (int rb = bid; rb < 256; rb += G) {
        const int b = rb / 64;
        __syncthreads();
        for (int k = tid; k < DM; k += 512) { lg[k] = mod[b * NMOD + 2 * DM + k] * P.g_post_mix[k]; la[k] = P.g_pre_ffn[k] * (1.0f + mod[b * NMOD + 4 * DM + k]); ls[k] = mod[b * NMOD + 3 * DM + k]; }
        __syncthreads();
        for (int i = 0; i < 4; ++i) {
            const int row = rb * 32 + wave * 4 + i;
            const float* mrow = MIX + (size_t)row * DM; const float* xrow = P.x + (size_t)row * DM; float* orow = P.out + (size_t)row * DM;
            f32x4 v[8]; float ss = 0.f;
#pragma unroll
            for (int j = 0; j < 8; ++j) { v[j] = *((const f32x4*)mrow + lane + 64 * j); ss += (v[j].x * v[j].x + v[j].y * v[j].y) + (v[j].z * v[j].z + v[j].w * v[j].w); }
            const float inv = 1.0f / sqrtf(wave_sum(ss) * (1.0f / DM) + EPS); float s2 = 0.f;
#pragma unroll
            for (int j = 0; j < 8; ++j) { const f32x4 xv = *((const f32x4*)xrow + lane + 64 * j), gv = *((const LAS f32x4*)lg + lane + 64 * j);
                v[j] = xv + v[j] * inv * gv; *((f32x4*)orow + lane + 64 * j) = v[j]; s2 += (v[j].x * v[j].x + v[j].y * v[j].y) + (v[j].z * v[j].z + v[j].w * v[j].w); }
            const float inv2 = 1.0f / sqrtf(wave_sum(s2) * (1.0f / DM) + EPS);
#pragma unroll
            for (int j = 0; j < 8; ++j) { const f32x4 av = *((const LAS f32x4*)la + lane + 64 * j), sv = *((const LAS f32x4*)ls + lane + 64 * j);
                const f32x4 y = v[j] * inv2 * av + sv; u32x2 o; o.x = pk2(y.x, y.y); o.y = pk2(y.z, y.w); *((u32x2*)(H + (size_t)row * DM) + lane + 64 * j) = o; }
        }
    }
}
__device__ __forceinline__ void p9_rows(const Ptrs& P, int bid, int G, LAS unsigned char* lds) {
    const int tid = threadIdx.x, lane = tid & 63, wave = tid >> 6;
    const float* mod = (const float*)(P.ws + WS_MOD); const float* FFN = (const float*)(P.ws + WS_MIX);
    LAS float* lg = (LAS float*)lds;
    for (int rb = bid; rb < 256; rb += G) {
        const int b = rb / 64;
        __syncthreads();
        for (int k = tid; k < DM; k += 512) lg[k] = mod[b * NMOD + 5 * DM + k] * P.g_post_ffn[k];
        __syncthreads();
        for (int i = 0; i < 4; ++i) {
            const int row = rb * 32 + wave * 4 + i;
            const float* frow = FFN + (size_t)row * DM; float* orow = P.out + (size_t)row * DM;
            f32x4 v[8]; float ss = 0.f;
#pragma unroll
            for (int j = 0; j < 8; ++j) { v[j] = *((const f32x4*)frow + lane + 64 * j); ss += (v[j].x * v[j].x + v[j].y * v[j].y) + (v[j].z * v[j].z + v[j].w * v[j].w); }
            const float inv = 1.0f / sqrtf(wave_sum(ss) * (1.0f / DM) + EPS);
#pragma unroll
            for (int j = 0; j < 8; ++j) { const f32x4 xv = *((const f32x4*)orow + lane + 64 * j), gv = *((const LAS f32x4*)lg + lane + 64 * j);
                *((f32x4*)orow + lane + 64 * j) = xv + v[j] * inv * gv; }
        }
    }
}
__device__ __forceinline__ void p3_dp(const Ptrs& P, int bid, int G) {
    const int tid = threadIdx.x; const bf16_t* Pp = (const bf16_t*)(P.ws + WS_P); bf16_t* Dp = (bf16_t*)(P.ws + WS_DP);
    for (int rb = bid; rb < 256; rb += G) {
        const int cg = tid & 127, run = tid >> 7, grp = cg >> 5, hw = 1 << grp;
        const int t0 = rb * 32 + run * 8, b = t0 / SEQ, tl0 = t0 % SEQ;
        const bf16_t* base = Pp + (size_t)b * SEQ * POOLW + cg * 8;
        float sum[8];
#pragma unroll
        for (int e = 0; e < 8; ++e) sum[e] = 0.f;
        { const int lo = max(tl0 - hw, 0), hi = min(tl0 + hw, SEQ);
          for (int r = lo; r < hi; ++r) { const bf16x8 v = *(const bf16x8*)(base + (size_t)r * POOLW);
#pragma unroll
              for (int e = 0; e < 8; ++e) sum[e] += bf2f((unsigned short)v[e]); } }
        for (int i = 0; i < 8; ++i) {
            const int tl = tl0 + i; const int lo = max(tl - hw, 0), hi = min(tl + hw, SEQ); const float rc = 1.0f / (float)(hi - lo);
            const bf16x8 pv = *(const bf16x8*)(base + (size_t)tl * POOLW);
            u32x4 o; float d[8];
#pragma unroll
            for (int e = 0; e < 8; ++e) d[e] = sum[e] * rc - bf2f((unsigned short)pv[e]);
            o.x = pk2(d[0], d[1]); o.y = pk2(d[2], d[3]); o.z = pk2(d[4], d[5]); o.w = pk2(d[6], d[7]);
            *(u32x4*)(Dp + (size_t)(t0 + i) * POOLW + cg * 8) = o;
            if (i < 7) {
                if (tl + hw < SEQ) { const bf16x8 v = *(const bf16x8*)(base + (size_t)(tl + hw) * POOLW);
#pragma unroll
                    for (int e = 0; e < 8; ++e) sum[e] += bf2f((unsigned short)v[e]); }
                if (tl - hw >= 0) { const bf16x8 v = *(const bf16x8*)(base + (size_t)(tl - hw) * POOLW);
#pragma unroll
                    for (int e = 0; e < 8; ++e) sum[e] -= bf2f((unsigned short)v[e]); }
            }
        }
    }
}

__global__ void __launch_bounds__(512) k_p0(Ptrs P) { extern __shared__ __attribute__((aligned(16))) unsigned char lds[]; p0_prologue(P, blockIdx.x, gridDim.x, (LAS unsigned char*)lds); }
__global__ void __launch_bounds__(512) k_p1(Ptrs P) { extern __shared__ __attribute__((aligned(16))) unsigned char lds[]; p1_rows(P, blockIdx.x, gridDim.x, (LAS unsigned char*)lds); }
__global__ void __launch_bounds__(512) k_dp(Ptrs P) { p3_dp(P, blockIdx.x, gridDim.x); }
__global__ void __launch_bounds__(512) k_p6(Ptrs P) { extern __shared__ __attribute__((aligned(16))) unsigned char lds[]; p6_rows(P, blockIdx.x, gridDim.x, (LAS unsigned char*)lds); }
__global__ void __launch_bounds__(512) k_p9(Ptrs P) { extern __shared__ __attribute__((aligned(16))) unsigned char lds[]; p9_rows(P, blockIdx.x, gridDim.x, (LAS unsigned char*)lds); }

struct EpiInproj {
    bf16_t *Pb, *Q, *K, *V; const float* rope;
    __device__ __forceinline__ void operator()(int row, int col, float v0, float v1) const {
        const int region = col >> 10, cc = col & 1023;
        if (row < MLAT) {
            const int b = row / SEQ, t = row % SEQ; const size_t krow = (size_t)b * KVL + CTXL + t;
            if (region == 0) { Pb[(size_t)row * POOLW + cc] = (bf16_t)f2bf(v0); Pb[(size_t)row * POOLW + cc + 16] = (bf16_t)f2bf(v1); }
            else if (region == 3) { V[krow * ATTW + cc] = (bf16_t)f2bf(v0); V[krow * ATTW + cc + 16] = (bf16_t)f2bf(v1); }
            else {
                const int within = cc & 63, half = within >> 5, i = within & 31;
                const int pos = half ? (t & 63) : (t >> 6);
                const float cs = rope[pos * 16 + i], sn = rope[1024 + pos * 16 + i];
                float o0 = v0 * cs - v1 * sn, o1 = v0 * sn + v1 * cs;
                if (region == 1) { o0 *= QSCALE; o1 *= QSCALE; Q[(size_t)row * ATTW + cc] = (bf16_t)f2bf(o0); Q[(size_t)row * ATTW + cc + 16] = (bf16_t)f2bf(o1); }
                else { K[krow * ATTW + cc] = (bf16_t)f2bf(o0); K[krow * ATTW + cc + 16] = (bf16_t)f2bf(o1); }
            }
        } else {
            const int r = row - MLAT, b = r / CTXL, j = r % CTXL; const size_t krow = (size_t)b * KVL + j;
            if (region == 2) { K[krow * ATTW + cc] = (bf16_t)f2bf(v0); K[krow * ATTW + cc + 16] = (bf16_t)f2bf(v1); }
            else if (region == 3) { V[krow * ATTW + cc] = (bf16_t)f2bf(v0); V[krow * ATTW + cc + 16] = (bf16_t)f2bf(v1); }
        }
    }
};
struct EpiPool {
    bf16_t* MIXIN; const float* pool_scale;
    __device__ __forceinline__ void operator()(int row, int col, float v0, float v1) const {
        MIXIN[(size_t)row * DM + col] = (bf16_t)f2bf(v0 * pool_scale[col]); MIXIN[(size_t)row * DM + col + 16] = (bf16_t)f2bf(v1 * pool_scale[col + 16]); }
};
struct EpiF32 {
    float* C; int ldc;
    __device__ __forceinline__ void operator()(int row, int col, float v0, float v1) const { C[(size_t)row * ldc + col] = v0; C[(size_t)row * ldc + col + 16] = v1; }
};
struct EpiSwiglu {
    bf16_t* ACT;
    __device__ __forceinline__ void operator()(int row, int col, float g, float u) const {
        ACT[(size_t)row * DFF + col] = (bf16_t)f2bf(g / (1.0f + expf(-g)) * u); }
};
template <class Epi, bool DUAL>
__global__ void __launch_bounds__(256) k_sgemm(const bf16_t* A, int lda, const bf16_t* Bt, int ldb, int K, Epi E, int erow_off, int ecol_off) {
    const int tid = threadIdx.x, wave = tid >> 6, lane = tid & 63, fr = lane & 15, fq = lane >> 4;
    const int row0 = blockIdx.y * 64 + wave * 16, col0 = blockIdx.x * 64;
    f32x4 acc[4], acc2[4];
#pragma unroll
    for (int n = 0; n < 4; ++n) { acc[n] = (f32x4){0.f, 0.f, 0.f, 0.f}; acc2[n] = (f32x4){0.f, 0.f, 0.f, 0.f}; }
    const bf16_t* ap = A + (size_t)(row0 + fr) * lda + 8 * fq;
    const int brow0 = DUAL ? (256 * (col0 / 128) + (col0 % 128)) : col0;
    const bf16_t* bp = Bt + (size_t)(brow0 + fr) * ldb + 8 * fq;
    for (int k0 = 0; k0 < K; k0 += 32) {
        const bf16x8 a = *(const bf16x8*)(ap + k0);
#pragma unroll
        for (int n = 0; n < 4; ++n) {
            const bf16x8 b = *(const bf16x8*)(bp + (size_t)(16 * n) * ldb + k0);
            acc[n] = __builtin_amdgcn_mfma_f32_16x16x32_bf16(a, b, acc[n], 0, 0, 0);
            if (DUAL) { const bf16x8 b2 = *(const bf16x8*)(bp + (size_t)(128 + 16 * n) * ldb + k0); acc2[n] = __builtin_amdgcn_mfma_f32_16x16x32_bf16(a, b2, acc2[n], 0, 0, 0); }
        }
    }
#pragma unroll
    for (int i = 0; i < 4; ++i) {
        const int row = erow_off + row0 + 4 * fq + i;
        if (DUAL) {
#pragma unroll
            for (int n = 0; n < 4; ++n) E(row, ecol_off + col0 + 16 * n + fr, acc[n][i], acc2[n][i]);
        } else {
            E(row, ecol_off + col0 + fr, acc[0][i], acc[1][i]);
            E(row, ecol_off + col0 + 32 + fr, acc[2][i], acc[3][i]);
        }
    }
}
__global__ void __launch_bounds__(256) k_sattn(Ptrs P) {
    __shared__ float sc[4][KVL];
    const int tid = threadIdx.x, wave = tid >> 6, lane = tid & 63;
    const int row = blockIdx.x * 4 + wave, h = blockIdx.y, b = row / SEQ;
    const bf16_t* Q = (const bf16_t*)(P.ws + WS_Q); const bf16_t* Kb = (const bf16_t*)(P.ws + WS_K) + (size_t)b * KVL * ATTW + h * VHD;
    const bf16_t* Vb = (const bf16_t*)(P.ws + WS_V) + (size_t)b * KVL * ATTW + h * VHD;
    const float lam = ((const float*)(P.ws + WS_ROPE))[2048];
    float o[2][2];
    for (int map = 0; map < 2; ++map) {
        float q[64];
#pragma unroll
        for (int d8 = 0; d8 < 8; ++d8) { const bf16x8 v = *(const bf16x8*)(Q + (size_t)row * ATTW + h * VHD + map * 64 + d8 * 8);
#pragma unroll
            for (int e = 0; e < 8; ++e) q[d8 * 8 + e] = bf2f((unsigned short)v[e]); }
        float mx = -1e30f;
        for (int i = 0; i < KVL / 64; ++i) { const int key = lane + 64 * i; const bf16_t* kp = Kb + (size_t)key * ATTW + map * 64; float s = 0.f;
#pragma unroll
            for (int d8 = 0; d8 < 8; ++d8) { const bf16x8 v = *(const bf16x8*)(kp + d8 * 8);
#pragma unroll
                for (int e = 0; e < 8; ++e) s += q[d8 * 8 + e] * bf2f((unsigned short)v[e]); }
            sc[wave][key] = s; mx = fmaxf(mx, s); }
        mx = wave_max(mx); float l = 0.f;
        for (int i = 0; i < KVL / 64; ++i) { const int key = lane + 64 * i; const float p = exp2f(sc[wave][key] - mx); sc[wave][key] = p; l += p; }
        l = wave_sum(l);
        __syncthreads();
        float a0 = 0.f, a1 = 0.f;
        for (int key = 0; key < KVL; ++key) { const float p = sc[wave][key]; const unsigned vv = *(const unsigned*)(Vb + (size_t)key * ATTW + 2 * lane);
            a0 += p * bf2f((unsigned short)(vv & 0xffffu)); a1 += p * bf2f((unsigned short)(vv >> 16)); }
        o[map][0] = a0 / l; o[map][1] = a1 / l;
    }
    const float d0 = o[0][0] - lam * o[1][0], d1 = o[0][1] - lam * o[1][1];
    const float ss = wave_sum(d0 * d0 + d1 * d1);
    const float inv = 1.0f / sqrtf(ss * (1.0f / VHD) + EPS) * (1.0f - LAMBDA_INIT);
    bf16_t* MIXIN = (bf16_t*)(P.ws + WS_MIXIN);
    *(unsigned*)(MIXIN + (size_t)row * DM + POOLW + h * VHD + 2 * lane) = pk2(d0 * inv * P.g_subln[2 * lane], d1 * inv * P.g_subln[2 * lane + 1]);
}

namespace pg8 {
constexpr int BM = 256, BK = 64, HALF = 128, HTB = HALF * BK * 2  , STAGE_BYTES = 8 * HTB, NXCD = 8, WGM = 8;
__host__ __device__ __forceinline__ int lds_byte(int r, int c) { const int st = (r >> 4) * 2 + (c >> 5), rr = r & 15, cc = c & 31, ob = rr * 64 + cc * 2; return st * 1024 + (ob ^ (((ob >> 9) & 1) << 5)); }
__host__ __device__ __forceinline__ void stage_rc(int b, int& R, int& C) { const int st = b / 1024, sb = b % 1024, swz = sb ^ (((sb >> 9) & 1) << 5); R = (st >> 1) * 16 + swz / 64; C = (st & 1) * 32 + (swz % 64) / 2; }
__host__ __device__ __forceinline__ int perm32(int rho) { const int n = rho >> 4, i = rho & 15; return 8 * (i >> 2) + 4 * n + (i & 3); }

struct Unit { int pm, pn; };
struct Gemm { const bf16_t* A; const bf16_t* Bt; int lda, ldb, K; };

__device__ __forceinline__ void std_unit(int L, int nM, int nN, Unit& u) {
    const int nwg = nM * nN; int wgid = L; { const int q = nwg / NXCD, r = nwg % NXCD, xcd = wgid % NXCD, off = wgid / NXCD; wgid = (xcd < r ? xcd * (q + 1) : r * (q + 1) + (xcd - r) * q) + off; }
    const int nig = WGM * nN, gid = wgid / nig, fm = gid * WGM, gsz = (nM - fm) < WGM ? (nM - fm) : WGM;
    u.pm = fm + ((wgid % nig) % gsz); u.pn = (wgid % nig) / gsz;
}
struct SchedStd {
    int nM, nN, G, c, lda, ldb;
    __device__ __forceinline__ bool next(int i, Unit& u) const { const int L = i * G + c; if (L >= nM * nN) return false; std_unit(L, nM, nN, u); return true; }
    __device__ __forceinline__ size_t aoff(const Unit& u) const { return (size_t)u.pm * 256 * lda * 2; }
    __device__ __forceinline__ size_t boff(const Unit& u) const { return (size_t)u.pn * 256 * ldb * 2; }
};
struct SchedInproj {
    int G, c;
    __device__ __forceinline__ bool next(int i, Unit& u) const { const int L = i * G + c; if (L >= 512 + 32) return false;
        if (L < 512) std_unit(L, 32, 16, u); else { const int j = L - 512; u.pm = 32 + (j >> 3); u.pn = 8 + (j & 7); } return true; }
    __device__ __forceinline__ size_t aoff(const Unit& u) const { return (size_t)u.pm * 256 * DM * 2; }
    __device__ __forceinline__ size_t boff(const Unit& u) const { return (size_t)u.pn * 256 * DM * 2; }
};
struct SchedPool {
    int G, c;
    __device__ __forceinline__ bool next(int i, Unit& u) const { const int L = i * G + c; if (L >= 128) return false; u.pm = L >> 2; u.pn = L & 3; return true; }
    __device__ __forceinline__ size_t aoff(const Unit& u) const { return ((size_t)u.pm * 256 * POOLW + (size_t)u.pn * 256) * 2; }
    __device__ __forceinline__ size_t boff(const Unit& u) const { return (size_t)u.pn * 65536 * 2; }
};

__device__ __forceinline__ u32x2 pk4(const f32x4 v) { u32x2 o; o.x = pk2(v[0], v[1]); o.y = pk2(v[2], v[3]); return o; }
struct EpiInprojF {
    static constexpr bool PERM = false;
    bf16_t *Pb, *Q, *K, *V; const float* rope;
    __device__ __forceinline__ void operator()(const f32x4 (&acc)[2][2][4][2], const Unit& u, int wr, int wc, int fr, int fq) const {
        const int region = u.pn >> 2, cbase = (u.pn & 3) * 256 + wc * 32 + 4 * fq;
        const bool lat = u.pm < 32;
#pragma unroll
        for (int ai = 0; ai < 2; ++ai)
#pragma unroll
            for (int m = 0; m < 4; ++m) {
                const int lr = 128 * ai + 64 * wr + 16 * m + fr;
                const int b = lat ? (u.pm >> 3) : (u.pm - 32), t = (u.pm & 7) * 256 + lr;
                const size_t grow = (size_t)u.pm * 256 + lr, krow = lat ? ((size_t)b * KVL + CTXL + t) : ((size_t)b * KVL + lr);
                if (region == 0) {
#pragma unroll
                    for (int bj = 0; bj < 2; ++bj)
#pragma unroll
                        for (int n = 0; n < 2; ++n) *(u32x2*)(Pb + grow * POOLW + cbase + 128 * bj + 16 * n) = pk4(acc[ai][bj][m][n]);
                } else if (region == 3) {
#pragma unroll
                    for (int bj = 0; bj < 2; ++bj)
#pragma unroll
                        for (int n = 0; n < 2; ++n) *(u32x2*)(V + krow * ATTW + cbase + 128 * bj + 16 * n) = pk4(acc[ai][bj][m][n]);
                } else if (!lat) {
#pragma unroll
                    for (int bj = 0; bj < 2; ++bj)
#pragma unroll
                        for (int n = 0; n < 2; ++n) *(u32x2*)(K + krow * ATTW + cbase + 128 * bj + 16 * n) = pk4(acc[ai][bj][m][n]);
                } else {
                    const int pos = (wc & 1) ? (t & 63) : (t >> 6);
                    const f32x4 cs = *(const f32x4*)(rope + pos * 16 + 4 * fq), sn = *(const f32x4*)(rope + 1024 + pos * 16 + 4 * fq);
#pragma unroll
                    for (int bj = 0; bj < 2; ++bj) {
                        const f32x4 x1 = acc[ai][bj][m][0], x2 = acc[ai][bj][m][1];
                        f32x4 o1 = x1 * cs - x2 * sn, o2 = x1 * sn + x2 * cs;
                        if (region == 1) { o1 = o1 * QSCALE; o2 = o2 * QSCALE;
                            *(u32x2*)(Q + grow * ATTW + cbase + 128 * bj) = pk4(o1); *(u32x2*)(Q + grow * ATTW + cbase + 128 * bj + 16) = pk4(o2); }
                        else { *(u32x2*)(K + krow * ATTW + cbase + 128 * bj) = pk4(o1); *(u32x2*)(K + krow * ATTW + cbase + 128 * bj + 16) = pk4(o2); }
                    }
                }
            }
    }
};
struct EpiPoolF {
    static constexpr bool PERM = true;
    bf16_t* MIXIN; const float* pool_scale;
    __device__ __forceinline__ void operator()(const f32x4 (&acc)[2][2][4][2], const Unit& u, int wr, int wc, int fr, int fq) const {
        const int col0 = u.pn * 256 + wc * 32 + 8 * fq;
        f32x4 sv[2][2];
#pragma unroll
        for (int bj = 0; bj < 2; ++bj)
#pragma unroll
            for (int n = 0; n < 2; ++n) sv[bj][n] = *(const f32x4*)(pool_scale + col0 + bj * HALF + 4 * n);
#pragma unroll
        for (int ai = 0; ai < 2; ++ai)
#pragma unroll
            for (int m = 0; m < 4; ++m) { bf16_t* rowp = MIXIN + ((size_t)u.pm * 256 + 128 * ai + 64 * wr + 16 * m + fr) * DM + col0;
#pragma unroll
                for (int bj = 0; bj < 2; ++bj) { const f32x4 v0 = acc[ai][bj][m][0] * sv[bj][0], v1 = acc[ai][bj][m][1] * sv[bj][1];
                    u32x4 w; w.x = pk2(v0[0], v0[1]); w.y = pk2(v0[2], v0[3]); w.z = pk2(v1[0], v1[1]); w.w = pk2(v1[2], v1[3]); *(u32x4*)(rowp + bj * HALF) = w; } }
    }
};
struct EpiF32F {
    static constexpr bool PERM = false;
    float* C; int ldc;
    __device__ __forceinline__ void operator()(const f32x4 (&acc)[2][2][4][2], const Unit& u, int wr, int wc, int fr, int fq) const {
        const int col0 = u.pn * 256 + wc * 32 + 4 * fq;
#pragma unroll
        for (int ai = 0; ai < 2; ++ai)
#pragma unroll
            for (int m = 0; m < 4; ++m) { float* rowp = C + ((size_t)u.pm * 256 + 128 * ai + 64 * wr + 16 * m + fr) * ldc + col0;
#pragma unroll
                for (int bj = 0; bj < 2; ++bj)
#pragma unroll
                    for (int n = 0; n < 2; ++n) *(f32x4*)(rowp + bj * HALF + n * 16) = acc[ai][bj][m][n]; }
    }
};
struct EpiSwigluF {
    static constexpr bool PERM = true;
    bf16_t* ACT;
    __device__ __forceinline__ void operator()(const f32x4 (&acc)[2][2][4][2], const Unit& u, int wr, int wc, int fr, int fq) const {
        const int col0 = u.pn * 128 + wc * 32 + 8 * fq;
#pragma unroll
        for (int ai = 0; ai < 2; ++ai)
#pragma unroll
            for (int m = 0; m < 4; ++m) { bf16_t* rowp = ACT + ((size_t)u.pm * 256 + 128 * ai + 64 * wr + 16 * m + fr) * DFF + col0;
                float r[8];
#pragma unroll
                for (int n = 0; n < 2; ++n)
#pragma unroll
                    for (int e = 0; e < 4; ++e) { const float g = acc[ai][0][m][n][e], uu = acc[ai][1][m][n][e];
                        r[4 * n + e] = g * uu * __builtin_amdgcn_rcpf(1.0f + __builtin_amdgcn_exp2f(-1.4426950408889634f * g)); }
                u32x4 w; w.x = pk2(r[0], r[1]); w.y = pk2(r[2], r[3]); w.z = pk2(r[4], r[5]); w.w = pk2(r[6], r[7]); *(u32x4*)rowp = w; }
    }
};

template <class Epi, class Sched, bool ALIGN_EPI>
__device__ __forceinline__ void gemm_phase(LAS unsigned char* lds, const Gemm g, const Sched& S, const Epi& E) {
    const int tid = threadIdx.x, wid = __builtin_amdgcn_readfirstlane(tid >> 6), lane = tid & 63, wr = wid >> 2, wc = wid & 3, fr = lane & 15, fq = lane >> 4;
    const int K = g.K, nt = K / BK;
    unsigned voffA[2], voffB[2];
#pragma unroll
    for (int i = 0; i < 2; ++i) { int R, C; stage_rc(tid * 16 + i * 8192, R, C); const int Rb = Epi::PERM ? ((R & ~31) + perm32(R & 31)) : R;
        voffA[i] = (unsigned)(R * g.lda + C) * 2u; voffB[i] = (unsigned)(Rb * g.ldb + C) * 2u; }
    const size_t kstep = (size_t)(BK * 2);
    const size_t hstepA = (size_t)HALF * g.lda * 2, hstepB = (size_t)HALF * g.ldb * 2;
    const unsigned ldsw = (unsigned)wid * 1024u;
    const int aoff = lds_byte(wr * 64 + fr, fq * 8), boff = lds_byte(wc * 32 + fr, fq * 8);
#define PG8_SA(b, h) (((b) * 2 + (h)) * HTB)
#define PG8_SB(b, h) ((4 + (b) * 2 + (h)) * HTB)
#define PG8_STAGE(bufoff, gbase, voff) do { _Pragma("unroll") for (int _i = 0; _i < 2; ++_i) \
        __builtin_amdgcn_global_load_lds((const unsigned*)((const char*)(gbase) + (voff)[_i]), (LAS unsigned*)(lds + (bufoff) + ldsw + _i * 8192), 16, 0, 0); } while (0)
#define PG8_LDA(dst, b, h) do { _Pragma("unroll") for (int m = 0; m < 4; ++m) _Pragma("unroll") for (int k = 0; k < 2; ++k) dst[m][k] = *(const LAS bf16x8*)(lds + PG8_SA(b, h) + aoff + m * 2048 + k * 1024); } while (0)
#define PG8_LDB(dst, b, h) do { _Pragma("unroll") for (int n = 0; n < 2; ++n) _Pragma("unroll") for (int k = 0; k < 2; ++k) dst[n][k] = *(const LAS bf16x8*)(lds + PG8_SB(b, h) + boff + n * 2048 + k * 1024); } while (0)
#define PG8_MMA(ai, bj, At, Bt) do { __builtin_amdgcn_s_setprio(1); _Pragma("unroll") for (int m = 0; m < 4; ++m) _Pragma("unroll") for (int n = 0; n < 2; ++n) _Pragma("unroll") for (int k = 0; k < 2; ++k) \
        acc[ai][bj][m][n] = __builtin_amdgcn_mfma_f32_16x16x32_bf16(Bt[n][k], At[m][k], acc[ai][bj][m][n], 0, 0, 0); __builtin_amdgcn_s_setprio(0); } while (0)
#define PG8_WAIT_V(n) asm volatile("s_waitcnt vmcnt(" #n ")" ::: "memory")
#define PG8_WAIT_L(n) asm volatile("s_waitcnt lgkmcnt(" #n ")" ::: "memory")
#define PG8_BAR __builtin_amdgcn_s_barrier()
#define PG8_SCHED __builtin_amdgcn_sched_barrier(0)
    Unit cur, nxt; int ui = 0;
    if (!S.next(0, cur)) return;
    f32x4 acc[2][2][4][2];
#pragma unroll
    for (int a = 0; a < 2; ++a)
#pragma unroll
        for (int b = 0; b < 2; ++b)
#pragma unroll
            for (int m = 0; m < 4; ++m)
#pragma unroll
                for (int n = 0; n < 2; ++n) acc[a][b][m][n] = (f32x4){0.f, 0.f, 0.f, 0.f};
    bf16x8 At[4][2], B0[2][2], B1[2][2];
    const char* cA = (const char*)g.A + S.aoff(cur); const char* cB = (const char*)g.Bt + S.boff(cur);
    PG8_STAGE(PG8_SB(0, 0), cB, voffB); PG8_STAGE(PG8_SB(0, 1), cB + hstepB, voffB); PG8_STAGE(PG8_SA(0, 0), cA, voffA); PG8_STAGE(PG8_SA(0, 1), cA + hstepA, voffA);
    if (wr == 1) PG8_BAR;
    PG8_WAIT_V(2); PG8_BAR;
    PG8_STAGE(PG8_SB(1, 0), cB + kstep, voffB); PG8_STAGE(PG8_SA(1, 0), cA + kstep, voffA); PG8_STAGE(PG8_SB(1, 1), cB + hstepB + kstep, voffB);
    PG8_WAIT_V(6); PG8_BAR;
    for (;;) {
        const bool has_next = S.next(ui + 1, nxt);
        const char* nA = has_next ? (const char*)g.A + S.aoff(nxt) : cA; const char* nB = has_next ? (const char*)g.Bt + S.boff(nxt) : cB;
#pragma unroll 1
        for (int t = 0; t < nt; t += 2) {
            const bool last = (t == nt - 2);
            const char* a1 = cA + (size_t)(t + 1) * kstep;
            const char* a2 = last ? nA : cA + (size_t)(t + 2) * kstep; const char* b2 = last ? nB : cB + (size_t)(t + 2) * kstep;
            const char* a3 = a2 + kstep; const char* b3 = b2 + kstep;
            PG8_LDB(B0, 0, 0); PG8_LDB(B1, 0, 1); PG8_SCHED; PG8_LDA(At, 0, 0); PG8_STAGE(PG8_SA(1, 1), a1 + hstepA, voffA);
            PG8_WAIT_V(8); PG8_WAIT_L(0); PG8_BAR; PG8_MMA(0, 0, At, B0); PG8_MMA(0, 1, At, B1); PG8_BAR; PG8_SCHED;
            PG8_LDA(At, 0, 1); PG8_STAGE(PG8_SB(0, 0), b2, voffB); PG8_STAGE(PG8_SB(0, 1), b2 + hstepB, voffB); PG8_STAGE(PG8_SA(0, 0), a2, voffA);
            PG8_WAIT_V(8); PG8_WAIT_L(0); PG8_BAR; PG8_MMA(1, 0, At, B0); PG8_MMA(1, 1, At, B1); PG8_BAR; PG8_SCHED;
            PG8_LDB(B0, 1, 0); PG8_LDB(B1, 1, 1); PG8_SCHED; PG8_LDA(At, 1, 0); PG8_STAGE(PG8_SA(0, 1), a2 + hstepA, voffA);
            PG8_WAIT_V(8); PG8_WAIT_L(0); PG8_BAR; PG8_MMA(0, 0, At, B0); PG8_MMA(0, 1, At, B1); PG8_BAR; PG8_SCHED;
            PG8_LDA(At, 1, 1); PG8_STAGE(PG8_SB(1, 0), b3, voffB); PG8_STAGE(PG8_SB(1, 1), b3 + hstepB, voffB); PG8_STAGE(PG8_SA(1, 0), a3, voffA);
            PG8_WAIT_V(8); PG8_WAIT_L(0); PG8_BAR; PG8_MMA(1, 0, At, B0); PG8_MMA(1, 1, At, B1); PG8_BAR; PG8_SCHED;
        }
        if constexpr (ALIGN_EPI) { if (wr == 0) PG8_BAR; }
        E(acc, cur, wr, wc, fr, fq);
        if (!has_next) break;
#pragma unroll
        for (int a = 0; a < 2; ++a)
#pragma unroll
            for (int b = 0; b < 2; ++b)
#pragma unroll
                for (int m = 0; m < 4; ++m)
#pragma unroll
                    for (int n = 0; n < 2; ++n) acc[a][b][m][n] = (f32x4){0.f, 0.f, 0.f, 0.f};
        cur = nxt; cA = nA; cB = nB; ++ui;
        if constexpr (ALIGN_EPI) { if (wr == 1) PG8_BAR; }
    }
    PG8_WAIT_V(0);
    if constexpr (!ALIGN_EPI) { if (wr == 0) PG8_BAR; }
    PG8_BAR;
#undef PG8_SA
#undef PG8_SB
#undef PG8_STAGE
#undef PG8_LDA
#undef PG8_LDB
#undef PG8_MMA
#undef PG8_WAIT_V
#undef PG8_WAIT_L
#undef PG8_BAR
#undef PG8_SCHED
}
}


namespace att {
typedef float f32x16 __attribute__((ext_vector_type(16)));
typedef short s16x4 __attribute__((ext_vector_type(4)));
constexpr int KVBLK = 64, LDK = ATTW, NT = KVL / KVBLK;
constexpr int SHM_V = 16384, SHM_K = 16384, OFF_V = 0, OFF_K = 2 * SHM_V, OFF_WS = 98304;
constexpr float THRL = 8.0f * 1.4426950408889634f;
#define KSWZ(row, colB) ((row) * 256 + ((colB) ^ (((row) & 7) << 4)))
#define SBAR() __builtin_amdgcn_sched_barrier(0)
__device__ __forceinline__ int crow(int r, int hi) { return (r & 3) + 8 * (r >> 2) + 4 * hi; }
__device__ __forceinline__ unsigned cvtpk(float lo, float hi) { unsigned r; asm volatile("v_cvt_pk_bf16_f32 %0, %1, %2" : "=v"(r) : "v"(lo), "v"(hi)); return r; }
__device__ __forceinline__ void partialSM(f32x16& p0, f32x16& p1, float& m_reg, float& mn, float& alpha) {
    float pmax = p0[0];
#pragma unroll
    for (int r = 1; r < 16; ++r) pmax = fmaxf(pmax, p0[r]);
#pragma unroll
    for (int r = 0; r < 16; ++r) pmax = fmaxf(pmax, p1[r]);
    { auto rr = __builtin_amdgcn_permlane32_swap(__float_as_uint(pmax), __float_as_uint(pmax), false, false);
      pmax = fmaxf(__uint_as_float(rr[0]), __uint_as_float(rr[1])); }
    if (__builtin_expect(__all(pmax - m_reg <= THRL), 1)) { mn = m_reg; alpha = 1.f; }
    else { mn = fmaxf(m_reg, pmax); alpha = __builtin_amdgcn_exp2f(m_reg - mn); m_reg = mn; }
#pragma unroll
    for (int r = 0; r < 16; ++r) p0[r] = p0[r] - mn;
#pragma unroll
    for (int r = 0; r < 16; ++r) p1[r] = p1[r] - mn;
#pragma unroll
    for (int r = 0; r < 16; ++r) p0[r] = __builtin_amdgcn_exp2f(p0[r]);
}
__device__ __forceinline__ void finishSM(f32x16& p0, f32x16& p1, float alpha, float& l_reg, bf16x8& pa0, bf16x8& pa1, bf16x8& pa2, bf16x8& pa3) {
#pragma unroll
    for (int r = 0; r < 16; ++r) p1[r] = __builtin_amdgcn_exp2f(p1[r]);
    float ps = 0;
#pragma unroll
    for (int r = 0; r < 16; ++r) ps += p0[r];
#pragma unroll
    for (int r = 0; r < 16; ++r) ps += p1[r];
    { auto rr = __builtin_amdgcn_permlane32_swap(__float_as_uint(ps), __float_as_uint(ps), false, false);
      ps = __uint_as_float(rr[0]) + __uint_as_float(rr[1]); }
    l_reg = l_reg * alpha + ps;
#define PK4(P, BASE, OUT) do { unsigned a0 = cvtpk(P[BASE + 0], P[BASE + 1]), a1 = cvtpk(P[BASE + 2], P[BASE + 3]);   \
    unsigned b0 = cvtpk(P[BASE + 4], P[BASE + 5]), b1 = cvtpk(P[BASE + 6], P[BASE + 7]);                              \
    auto r0 = __builtin_amdgcn_permlane32_swap(a0, b0, false, false); auto r1 = __builtin_amdgcn_permlane32_swap(a1, b1, false, false); \
    u32x4 w = {r0[0], r1[0], r0[1], r1[1]}; OUT = __builtin_bit_cast(bf16x8, w); } while (0)
    PK4(p0, 0, pa0); PK4(p0, 8, pa1); PK4(p1, 0, pa2); PK4(p1, 8, pa3);
#undef PK4
}
__device__ __forceinline__ void qkt(f32x16& p0, f32x16& p1, const LAS unsigned char* Ks, const bf16x8* qr, int cb0, int r32, int hi) {
    p0 = f32x16{}; p1 = f32x16{};
#pragma unroll
    for (int d0 = 0; d0 < 4; ++d0) { const int cb = cb0 + (d0 * 16 + hi * 8) * 2;
        const bf16x8 b0 = *(const LAS bf16x8*)(Ks + KSWZ(r32, cb));
        const bf16x8 b1 = *(const LAS bf16x8*)(Ks + KSWZ(32 + r32, cb));
        p0 = __builtin_amdgcn_mfma_f32_32x32x16_bf16(b0, qr[d0], p0, 0, 0, 0);
        p1 = __builtin_amdgcn_mfma_f32_32x32x16_bf16(b1, qr[d0], p1, 0, 0, 0); }
}
__device__ __forceinline__ int v_st(int k, int c) { const int kk = (k & ~0xC) | ((k & 4) << 1) | ((k & 8) >> 1); return ((kk >> 3) * 4 + (c >> 5)) * 512 + ((kk & 7) * 32 + (c & 31)) * 2; }
__device__ __forceinline__ int v_rd_base(int lane) { return ((lane & 3) << 3) | (((lane >> 2) & 3) << 6) | (((lane >> 4) & 1) << 5) | (((lane >> 5) & 1) << 8); }
constexpr int v_rd_off(int d0, int ks, int half) { return d0 * 512 + ks * 4096 + half * 2048; }
template <int OFF> __device__ __forceinline__ s16x4 tr_read(int vb) {
    s16x4 r; asm volatile("ds_read_b64_tr_b16 %0, %1 offset:%2" : "=&v"(r) : "v"(vb), "i"(OFF) : "memory"); return r;
}
template <int D0> __device__ __forceinline__ void pv_one(f32x16& od, int vb, bf16x8 pa0, bf16x8 pa1, bf16x8 pa2, bf16x8 pa3) {
    const s16x4 l0 = tr_read<v_rd_off(D0, 0, 0)>(vb), h0 = tr_read<v_rd_off(D0, 0, 1)>(vb), l1 = tr_read<v_rd_off(D0, 1, 0)>(vb), h1 = tr_read<v_rd_off(D0, 1, 1)>(vb);
    const s16x4 l2 = tr_read<v_rd_off(D0, 2, 0)>(vb), h2 = tr_read<v_rd_off(D0, 2, 1)>(vb), l3 = tr_read<v_rd_off(D0, 3, 0)>(vb), h3 = tr_read<v_rd_off(D0, 3, 1)>(vb);
    asm volatile("s_waitcnt lgkmcnt(0)" ::: "memory"); SBAR();
#define PK(L, H) (bf16x8){L[0], L[1], L[2], L[3], H[0], H[1], H[2], H[3]}
    od = __builtin_amdgcn_mfma_f32_32x32x16_bf16(pa0, PK(l0, h0), od, 0, 0, 0);
    od = __builtin_amdgcn_mfma_f32_32x32x16_bf16(pa1, PK(l1, h1), od, 0, 0, 0);
    od = __builtin_amdgcn_mfma_f32_32x32x16_bf16(pa2, PK(l2, h2), od, 0, 0, 0);
    od = __builtin_amdgcn_mfma_f32_32x32x16_bf16(pa3, PK(l3, h3), od, 0, 0, 0);
#undef PK
}
__device__ __forceinline__ void pv_d0(f32x16* o, int vb, bf16x8 pa0, bf16x8 pa1, bf16x8 pa2, bf16x8 pa3) {
    pv_one<0>(o[0], vb, pa0, pa1, pa2, pa3); pv_one<1>(o[1], vb, pa0, pa1, pa2, pa3); pv_one<2>(o[2], vb, pa0, pa1, pa2, pa3); pv_one<3>(o[3], vb, pa0, pa1, pa2, pa3);
}
__device__ __forceinline__ void attn_unit(const Ptrs& P, int b, int h, int qb, LAS unsigned char* lds, float lam) {
    const int tid = threadIdx.x, wid = __builtin_amdgcn_readfirstlane(tid >> 6), lane = tid & 63, r32 = lane & 31, hi = lane >> 5;
    const int pair = wid >> 1, map = wid & 1;
    const bf16_t* Kh = (const bf16_t*)(P.ws + WS_K) + (size_t)b * KVL * ATTW + h * VHD;
    const bf16_t* Vh = (const bf16_t*)(P.ws + WS_V) + (size_t)b * KVL * ATTW + h * VHD;
    const size_t qrow = (size_t)b * SEQ + qb * 128 + pair * 32 + r32;
    LAS float* wsf = (LAS float*)(lds + OFF_WS) + wid * 64; LAS float* li_l = wsf; LAS float* al_l = wsf + 32;
    float m_reg = -1e30f, l_reg = 0; f32x16 o[4] = {}; bf16x8 qr[4];
    { const bf16_t* Qw = (const bf16_t*)(P.ws + WS_Q) + qrow * ATTW + h * VHD + map * 64 + hi * 8;
#pragma unroll
      for (int d0 = 0; d0 < 4; ++d0) qr[d0] = *(const bf16x8*)(Qw + d0 * 16); }
    const int cb0 = map * 128;
    const int sr = tid >> 4, sc = (tid & 15) * 8, vst0 = v_st(sr, sc), vst1 = v_st(32 + sr, sc);
    const int vb0 = (int)(unsigned)(uintptr_t)(lds + OFF_V) + v_rd_base(lane);
    struct { bf16x8 vs0, vs1, ks0, ks1; } sr_[2];
#define SLOAD(i, k0) do { sr_[i].vs0 = *(const bf16x8*)(&Vh[(size_t)((k0) + sr) * LDK + sc]); sr_[i].vs1 = *(const bf16x8*)(&Vh[(size_t)((k0) + 32 + sr) * LDK + sc]); \
    sr_[i].ks0 = *(const bf16x8*)(&Kh[(size_t)((k0) + sr) * LDK + sc]); sr_[i].ks1 = *(const bf16x8*)(&Kh[(size_t)((k0) + 32 + sr) * LDK + sc]); } while (0)
#define SWRITE(bb, i) do { *(LAS bf16x8*)(lds + OFF_V + (bb) * SHM_V + vst0) = sr_[i].vs0; *(LAS bf16x8*)(lds + OFF_V + (bb) * SHM_V + vst1) = sr_[i].vs1; const int kc = sc * 2; \
    *(LAS bf16x8*)(lds + OFF_K + (bb) * SHM_K + KSWZ(sr, kc)) = sr_[i].ks0; *(LAS bf16x8*)(lds + OFF_K + (bb) * SHM_K + KSWZ(32 + sr, kc)) = sr_[i].ks1; } while (0)
#define SWAIT() asm volatile("s_waitcnt vmcnt(4)" ::: "memory")
#define RESC(a) do { if (__any((a) < 1.f)) { if (hi == 0) al_l[r32] = (a); asm volatile("s_waitcnt lgkmcnt(0)" ::: "memory"); \
    _Pragma("unroll") for (int d = 0; d < 4; ++d) _Pragma("unroll") for (int r = 0; r < 16; ++r) o[d][r] *= al_l[crow(r, hi)]; } } while (0)
    f32x16 pA0, pA1, pB0, pB1; float mnA, mnB, alA, alB; bf16x8 pa0, pa1, pa2, pa3;
    const LAS unsigned char* K0 = lds + OFF_K; const LAS unsigned char* K1 = lds + OFF_K + SHM_K;
    SLOAD(0, 0); asm volatile("s_waitcnt vmcnt(0)" ::: "memory"); SWRITE(0, 0); __syncthreads();
    qkt(pA0, pA1, K0, qr, cb0, r32, hi); partialSM(pA0, pA1, m_reg, mnA, alA);
    SLOAD(1, KVBLK); SLOAD(0, 2 * KVBLK);
    SWAIT(); SWRITE(1, 1); __syncthreads();
    for (int j = 1; j + 1 < NT; j += 2) {
        SBAR(); qkt(pB0, pB1, K1, qr, cb0, r32, hi);
        finishSM(pA0, pA1, alA, l_reg, pa0, pa1, pa2, pa3); SBAR();
        SLOAD(1, (j + 2) * KVBLK); SBAR();
        pv_d0(o, vb0, pa0, pa1, pa2, pa3); partialSM(pB0, pB1, m_reg, mnB, alB);
        __syncthreads(); SWAIT(); SWRITE(0, 0);
        RESC(alB); __syncthreads();
        SBAR(); qkt(pA0, pA1, K0, qr, cb0, r32, hi);
        finishSM(pB0, pB1, alB, l_reg, pa0, pa1, pa2, pa3); SBAR();
        if (j + 3 < NT) SLOAD(0, (j + 3) * KVBLK); SBAR();
        pv_d0(o, vb0 + SHM_V, pa0, pa1, pa2, pa3); partialSM(pA0, pA1, m_reg, mnA, alA);
        __syncthreads(); SWAIT(); SWRITE(1, 1);
        RESC(alA); __syncthreads();
    }
    SBAR(); qkt(pB0, pB1, K1, qr, cb0, r32, hi);
    finishSM(pA0, pA1, alA, l_reg, pa0, pa1, pa2, pa3); SBAR();
    pv_d0(o, vb0, pa0, pa1, pa2, pa3); partialSM(pB0, pB1, m_reg, mnB, alB);
    __syncthreads(); RESC(alB);
    finishSM(pB0, pB1, alB, l_reg, pa0, pa1, pa2, pa3); SBAR();
    pv_d0(o, vb0 + SHM_V, pa0, pa1, pa2, pa3);
    if (hi == 0) li_l[r32] = l_reg; asm volatile("s_waitcnt lgkmcnt(0)" ::: "memory");
    const float osc = map ? lam : 1.0f;
#pragma unroll
    for (int r = 0; r < 16; ++r) { const float rl = __builtin_amdgcn_rcpf(li_l[crow(r, hi)]) * osc;
#pragma unroll
        for (int d0 = 0; d0 < 4; ++d0) o[d0][r] *= rl; }
    __syncthreads();
    LAS float* X = (LAS float*)(lds + pair * 17408);
    if (map == 1) {
#pragma unroll
        for (int d0 = 0; d0 < 4; ++d0)
#pragma unroll
            for (int r = 0; r < 16; ++r) X[(d0 * 16 + r) * 64 + lane] = o[d0][r];
    }
    __syncthreads();
    if (map == 0) {
#pragma unroll
        for (int d0 = 0; d0 < 4; ++d0)
#pragma unroll
            for (int r = 0; r < 16; ++r) o[d0][r] -= X[(d0 * 16 + r) * 64 + lane];
        asm volatile("s_waitcnt lgkmcnt(0)" ::: "memory");
        LAS float* Yw = X + (4 * hi) * 132 + r32;
#pragma unroll
        for (int d0 = 0; d0 < 4; ++d0)
#pragma unroll
            for (int r = 0; r < 16; ++r) Yw[((r & 3) + 8 * (r >> 2)) * 132 + 32 * d0] = o[d0][r];
        asm volatile("s_waitcnt lgkmcnt(0)" ::: "memory");
        const LAS float* Yr = X + r32 * 132 + hi * 64;
        float ss = 0.f;
#pragma unroll
        for (int jj = 0; jj < 16; ++jj) { const f32x4 v = *(const LAS f32x4*)(Yr + jj * 4); ss += (v.x * v.x + v.y * v.y) + (v.z * v.z + v.w * v.w); }
        ss += __shfl_xor(ss, 32);
        const float inv = (1.0f - LAMBDA_INIT) / sqrtf(ss * (1.0f / VHD) + EPS);
        bf16_t* orow = (bf16_t*)(P.ws + WS_MIXIN) + qrow * DM + POOLW + h * VHD + hi * 64;
        const float* gs = P.g_subln + hi * 64;
#pragma unroll
        for (int jj = 0; jj < 16; jj += 2) { const f32x4 g0 = *(const f32x4*)(gs + jj * 4), g1 = *(const f32x4*)(gs + jj * 4 + 4);
            const f32x4 a = *(const LAS f32x4*)(Yr + jj * 4) * inv * g0, c = *(const LAS f32x4*)(Yr + jj * 4 + 4) * inv * g1;
            u32x4 w; w.x = pk2(a.x, a.y); w.y = pk2(a.z, a.w); w.z = pk2(c.x, c.y); w.w = pk2(c.z, c.w); *(u32x4*)(orow + jj * 4) = w; }
    }
    __syncthreads();
#undef SLOAD
#undef SWRITE
#undef SWAIT
#undef RESC
}
__device__ __forceinline__ void attn_phase(const Ptrs& P, int bid, int G, LAS unsigned char* lds) {
    const float lam = ((const float*)(P.ws + WS_ROPE))[2048];
    const int vcu = (G % 8 == 0) ? (bid % 8) * (G / 8) + bid / 8 : bid;
    for (int u = vcu; u < NB * NH * (SEQ / 128); u += G) { const int bh = u >> 4, qb = u & 15; attn_unit(P, bh >> 3, bh & 7, qb, lds, lam); }
}
#undef KSWZ
#undef SBAR
}

#define XB_TMO      128
#define XB_XCNT(j)  (256  + 64 * (j))
#define XB_XSUB(j)  (1280 + 64 * (j))
#define XB_XGEN(j)  (2304 + 64 * (j))
#define XB_TOP      3328
#define XB_TOPGEN   3392
#define XCD_BAR_WORDS 3456
#define XB_SPIN_CAP (1u << 18)
__device__ __forceinline__ unsigned xb_ld(unsigned* p)              { return __hip_atomic_load(p, __ATOMIC_RELAXED, __HIP_MEMORY_SCOPE_AGENT); }
__device__ __forceinline__ unsigned xb_add(unsigned* p, unsigned v) { return __hip_atomic_fetch_add(p, v, __ATOMIC_RELAXED, __HIP_MEMORY_SCOPE_AGENT); }
__device__ __forceinline__ unsigned xb_xcc_id() { return (unsigned)__builtin_amdgcn_s_getreg((3 << 11) | 20) & 0xFu; }
#define XB_SPIN(cond, bar) do { unsigned _sp = 0; while (cond) { __builtin_amdgcn_s_sleep(1); \
    if ((++_sp & 255u) == 0u) { if (xb_ld(&(bar)[XB_TMO])) break; if (_sp > XB_SPIN_CAP) { atomicAdd(&(bar)[XB_TMO], 1u); break; } } } } while (0)
struct XcdBarrier { unsigned* bar; unsigned x; volatile LAS unsigned* st; };
__device__ __forceinline__ XcdBarrier xcd_barrier_post(unsigned* bar, volatile LAS unsigned* st) {
    XcdBarrier b; b.bar = bar; b.x = xb_xcc_id(); b.st = st;
    if (threadIdx.x == 0) (void)xb_add(&bar[XB_XCNT(b.x)], 1u);
    return b;
}
__device__ __forceinline__ void xcd_barrier_complete(unsigned* bar, unsigned x, unsigned& nloc, unsigned& nx) {
    const unsigned G = gridDim.x * gridDim.y * gridDim.z;
    unsigned sum, cnt, mine, sp = 0u;
    for (;;) {
        sum = 0u; cnt = 0u; mine = 0u;
#pragma unroll
        for (unsigned j = 0; j < 16; ++j) { const unsigned c = xb_ld(&bar[XB_XCNT(j)]); sum += c; cnt += (c > 0u) ? 1u : 0u; mine = (j == x) ? c : mine; }
        if (sum == G) break;
        __builtin_amdgcn_s_sleep(1);
        if ((++sp & 255u) == 0u) { if (xb_ld(&bar[XB_TMO])) break; if (sp > XB_SPIN_CAP) { atomicAdd(&bar[XB_TMO], 1u); break; } }
    }
    nloc = mine > 0u ? mine : 1u; nx = cnt > 0u ? cnt : 1u;
}
__device__ __forceinline__ void xcd_barrier(const XcdBarrier& b) {
    asm volatile("s_waitcnt vmcnt(0)" ::: "memory");
    __syncthreads();
    if (threadIdx.x == 0) {
        unsigned* bar = b.bar;
        __builtin_amdgcn_s_waitcnt(0);
        unsigned nloc = b.st[0], nx = b.st[1];
        if (nloc == 0u) { xcd_barrier_complete(bar, b.x, nloc, nx); b.st[0] = nloc; b.st[1] = nx; }
        const unsigned old = xb_add(&bar[XB_XSUB(b.x)], 1u);
        const unsigned gen = old / nloc;
        if (old + 1u == (gen + 1u) * nloc) {
            __builtin_amdgcn_fence(__ATOMIC_RELEASE, "agent");
            asm volatile("s_waitcnt vmcnt(0)" ::: "memory");
            const unsigned og = xb_add(&bar[XB_TOP], 1u);
            const unsigned tg = og / nx;
            if (og + 1u == (tg + 1u) * nx) xb_add(&bar[XB_TOPGEN], 1u);
            else XB_SPIN(xb_ld(&bar[XB_TOPGEN]) == tg, bar);
            __builtin_amdgcn_fence(__ATOMIC_ACQUIRE, "agent");
            xb_add(&bar[XB_XGEN(b.x)], 1u);
            asm volatile("s_waitcnt vmcnt(0)" ::: "memory");
        } else {
            XB_SPIN(xb_ld(&bar[XB_XGEN(b.x)]) == gen, bar);
            __builtin_amdgcn_fence(__ATOMIC_ACQUIRE, "agent");
            asm volatile("s_waitcnt vmcnt(0)" ::: "memory");
        }
    }
    __syncthreads();
}

constexpr int RING_BYTES = 131072, LDSCTL_OFF = RING_BYTES, MISC_OFF = LDSCTL_OFF + 320, LDS_BYTES = 147456;
constexpr int CW_BAR = 4096;
constexpr int N_PHASES = 10;
#ifndef FAST_ATTN
#define FAST_ATTN 1
#endif
struct Args { Ptrs P; int ph_lo, ph_hi, li, pad; };
__global__ void __launch_bounds__(512, 2) mega_fwd(Args args) {
    extern __shared__ __attribute__((aligned(16))) unsigned char lds_raw[];
    LAS unsigned char* lds = (LAS unsigned char*)lds_raw;
    const Ptrs& P = args.P;
    const int tid = threadIdx.x, G = gridDim.x, bid = blockIdx.x;
    for (int u = tid; u < (LDS_BYTES - LDSCTL_OFF) / 4; u += 512) ((LAS unsigned*)(lds + LDSCTL_OFF))[u] = 0u;
    __syncthreads();
    volatile LAS unsigned* MISC = (volatile LAS unsigned*)(lds + MISC_OFF);
    unsigned* ctl = (unsigned*)(P.ws + WS_CTL);
    XcdBarrier bar = xcd_barrier_post(ctl + CW_BAR + args.li * XCD_BAR_WORDS, MISC + 8);
    const int lo = args.ph_lo, hi = args.ph_hi;
#ifndef DUP_MASK
#define DUP_MASK 0
#endif
#define REP(k) for (int rep_ = 0; rep_ < 1 + ((DUP_MASK >> (k)) & 1); ++rep_)
#ifdef PHASE_MASK
#define IN(k) (lo <= (k) && (k) < hi && ((PHASE_MASK >> (k)) & 1))
#else
#define IN(k) (lo <= (k) && (k) < hi)
#endif
#ifndef BAR_REP
#define BAR_REP 1
#endif
#define SEAM(k) do { if (IN(k) && IN((k) + 1)) { for (int br_ = 0; br_ < BAR_REP; ++br_) xcd_barrier(bar); } } while (0)
    unsigned char* ws = P.ws;
    bf16_t* H = (bf16_t*)(ws + WS_H);
    if (IN(0)) { REP(0) { p0_prologue(P, bid, G, lds); __syncthreads(); } SEAM(0); }
    if (IN(1)) { REP(1) { p1_rows(P, bid, G, lds); __syncthreads(); } SEAM(1); }
    if (IN(2)) {
        pg8::Gemm g{H, (const bf16_t*)(ws + WS_WIN), DM, DM, DM}; pg8::SchedInproj S{G, bid};
        pg8::EpiInprojF E{(bf16_t*)(ws + WS_P), (bf16_t*)(ws + WS_Q), (bf16_t*)(ws + WS_K), (bf16_t*)(ws + WS_V), (const float*)(ws + WS_ROPE)};
        REP(2) pg8::gemm_phase<pg8::EpiInprojF, pg8::SchedInproj, true>(lds, g, S, E);
        if (G == 256 && bid >= 32) convert_items(P, I_IN, I_OUT + I_GU, (bid - 32) * 8 + (tid >> 6), 224 * 8, lds);
        else if (G != 256) convert_items(P, I_IN, I_OUT + I_GU, bid * 8 + (tid >> 6), G * 8, lds);
        SEAM(2);
    }
    if (IN(3)) { REP(3) { p3_dp(P, bid, G);
#if FAST_ATTN
        att::attn_phase(P, bid, G, lds);
#endif
        } SEAM(3); }
    if (IN(4)) {
        pg8::Gemm g{(const bf16_t*)(ws + WS_DP), (const bf16_t*)(ws + WS_WPOOL), POOLW, 256, 256}; pg8::SchedPool S{G, bid};
        pg8::EpiPoolF E{(bf16_t*)(ws + WS_MIXIN), P.pool_scale};
        REP(4) pg8::gemm_phase<pg8::EpiPoolF, pg8::SchedPool, true>(lds, g, S, E);
        SEAM(4);
    }
    if (IN(5)) {
        pg8::Gemm g{(const bf16_t*)(ws + WS_MIXIN), (const bf16_t*)(ws + WS_WOUT), DM, DM, DM}; pg8::SchedStd S{32, 8, G, bid, DM, DM};
        pg8::EpiF32F E{(float*)(ws + WS_MIX), DM};
        REP(5) pg8::gemm_phase<pg8::EpiF32F, pg8::SchedStd, true>(lds, g, S, E);
        SEAM(5);
    }
    if (IN(6)) { REP(6) { p6_rows(P, bid, G, lds); __syncthreads(); } SEAM(6); }
    if (IN(7)) {
        pg8::Gemm g{H, (const bf16_t*)(ws + WS_WGU), DM, DM, DM}; pg8::SchedStd S{32, 44, G, bid, DM, DM};
        pg8::EpiSwigluF E{(bf16_t*)(ws + WS_ACT)};
        REP(7) pg8::gemm_phase<pg8::EpiSwigluF, pg8::SchedStd, true>(lds, g, S, E);
        if (G == 256 && bid >= 128) convert_items(P, I_IN + I_OUT + I_GU, I_DN, (bid - 128) * 8 + (tid >> 6), 128 * 8, lds);
        else if (G != 256) convert_items(P, I_IN + I_OUT + I_GU, I_DN, bid * 8 + (tid >> 6), G * 8, lds);
        SEAM(7);
    }
    if (IN(8)) {
        pg8::Gemm g{(const bf16_t*)(ws + WS_ACT), (const bf16_t*)(ws + WS_WDN), DFF, DFF, DFF}; pg8::SchedStd S{32, 8, G, bid, DFF, DFF};
        pg8::EpiF32F E{(float*)(ws + WS_MIX), DM};
        REP(8) pg8::gemm_phase<pg8::EpiF32F, pg8::SchedStd, true>(lds, g, S, E);
        SEAM(8);
    }
    if (IN(9)) { p9_rows(P, bid, G, lds); }
#undef IN
#undef SEAM
}

extern "C" void kernel_launch(void* const* d_in, const int* in_sizes, int n_in, void* d_out, int out_size, void* d_ws, size_t ws_size, hipStream_t stream) {
    static int ok = 0;
    if (ok == 0) {
        if (n_in != 21 || in_sizes[0] != MLAT * DM || out_size != MLAT * DM || ws_size < WS_END) {
            fprintf(stderr, "kernel_launch: unexpected shapes: n_in %d in0 %d out %d ws %zu (need >= %zu)\n", n_in, n_in > 0 ? in_sizes[0] : -1, out_size, ws_size, (size_t)WS_END); ok = -1; return; }
        if (hipFuncSetAttribute((const void*)mega_fwd, hipFuncAttributeMaxDynamicSharedMemorySize, LDS_BYTES) != hipSuccess) { fprintf(stderr, "kernel_launch: hipFuncSetAttribute failed\n"); ok = -1; return; }
        int dev = 0, cus = 0, per_cu = 0;
        if (hipGetDevice(&dev) != hipSuccess || hipDeviceGetAttribute(&cus, hipDeviceAttributeMultiprocessorCount, dev) != hipSuccess) { ok = -1; return; }
        if (hipOccupancyMaxActiveBlocksPerMultiprocessor(&per_cu, (const void*)mega_fwd, 512, LDS_BYTES) != hipSuccess || per_cu < 1) fprintf(stderr, "kernel_launch: occupancy query reports %d blocks per CU\n", per_cu);
        (void)hipGetLastError();
        if (cus != 256) fprintf(stderr, "kernel_launch: %d CUs (built for 256)\n", cus);
        ok = cus;
    }
    if (ok < 0) return;
    const int grid = ok;
    Ptrs P{};
#define IN_(i) ((const float*)d_in[i])
    P.x = IN_(0); P.c = IN_(1); P.ctx = IN_(2); P.c_ctx = IN_(3); P.w_ada = IN_(4); P.b_ada = IN_(5); P.g_pre_mix = IN_(6); P.g_post_mix = IN_(7);
    P.g_pre_ffn = IN_(8); P.g_post_ffn = IN_(9); P.w_in = IN_(10); P.w_pool = IN_(11); P.pool_scale = IN_(12); P.lq1 = IN_(13); P.lk1 = IN_(14);
    P.lq2 = IN_(15); P.lk2 = IN_(16); P.g_subln = IN_(17); P.w_out = IN_(18); P.w_gu = IN_(19); P.w_dn = IN_(20);
#undef IN_
    P.out = (float*)d_out; P.ws = (unsigned char*)d_ws;
    if (hipMemsetAsync((char*)d_ws + WS_CTL, 0, CTL_ZERO_BYTES, stream) != hipSuccess) { fprintf(stderr, "kernel_launch: hipMemsetAsync failed\n"); return; }
    Args a{}; a.P = P;
#if FAST_ATTN
    a.ph_lo = 0; a.ph_hi = N_PHASES; a.li = 0;
    hipLaunchKernelGGL(mega_fwd, dim3(grid), dim3(512), LDS_BYTES, stream, a);
#else
    a.ph_lo = 0; a.ph_hi = 4; a.li = 0;
    hipLaunchKernelGGL(mega_fwd, dim3(grid), dim3(512), LDS_BYTES, stream, a);
    hipLaunchKernelGGL(k_sattn, dim3(MLAT / 4, NH), dim3(256), 0, stream, P);
    a.ph_lo = 4; a.ph_hi = N_PHASES; a.li = 1;
    hipLaunchKernelGGL(mega_fwd, dim3(grid), dim3(512), LDS_BYTES, stream, a);
#endif
    const hipError_t le = hipPeekAtLastError();
    if (le != hipSuccess) fprintf(stderr, "kernel_launch: launch failed: %s\n", hipGetErrorName(le));
}
```
